# Optimizing an MI355X kernel written in HIP

```python
import math
import jax, jax.numpy as jnp
from jax import lax
import numpy as np

D_MODEL = 1024
BATCH = 4
SEQ = 8192
DEPTH = 4

GRID_W = 64
NA_HEADS = 8
NA_HEAD_DIM = 64
NA_WIN_ROWS = 8
NA_WIN_COLS = 16
NA_W = NA_HEADS * NA_HEAD_DIM
RET_HEADS = 4
RET_QK_DIM = 128
RET_V_DIM = 256
RET_CHUNK = 128
RET_QK_W = RET_HEADS * RET_QK_DIM
RET_V_W = RET_HEADS * RET_V_DIM
ROPE_BASE = 10000.0
IN_SIZES = (NA_W, NA_W, NA_W, RET_QK_W, RET_QK_W, RET_V_W, RET_V_W, D_MODEL, D_MODEL)
IN_SPLITS = tuple(int(s) for s in np.cumsum(IN_SIZES)[:-1])
D_IN = int(sum(IN_SIZES))
D_FF = 2816
CONV_W = 3
PLE_DIM = 256
LN_EPS = 1e-5
GN_EPS = 1e-6
DEEPNORM_ALPHA = (2.0 * DEPTH) ** 0.25
DEEPNORM_BETA = (8.0 * DEPTH) ** -0.25

kernel_name = "hybrid_na2d_retention_deepnorm_encoder"


def layer_norm(x, g, b):
    xf = x.astype(jnp.float32)
    mu = jnp.mean(xf, axis=-1, keepdims=True)
    var = jnp.mean(jnp.square(xf - mu), axis=-1, keepdims=True)
    y = (xf - mu) * lax.rsqrt(var + LN_EPS) * g.astype(jnp.float32) + b.astype(jnp.float32)
    return y.astype(x.dtype)


def rotary(x, pos):
    half = x.shape[-1] // 2
    inv = ROPE_BASE ** (-jnp.arange(half, dtype=jnp.float32) / half)
    ang = pos[:, None] * inv[None, :]
    cos, sin = jnp.cos(ang), jnp.sin(ang)
    x1, x2 = x[..., :half].astype(jnp.float32), x[..., half:].astype(jnp.float32)
    return jnp.concatenate([x1 * cos - x2 * sin, x2 * cos + x1 * sin], axis=-1).astype(x.dtype)


def neighbourhood_attention(q, k, v, rpb):
    B, T, H, dh = q.shape
    rows = T // GRID_W
    wr = min(NA_WIN_ROWS, rows)
    scale = dh ** -0.5
    q_g = q.reshape(B, rows, GRID_W, H, dh).transpose(1, 0, 3, 2, 4)
    k_g = k.reshape(B, rows, GRID_W, H, dh).transpose(0, 3, 1, 2, 4)
    v_g = v.reshape(B, rows, GRID_W, H, dh).transpose(0, 3, 1, 2, 4)
    cols = np.arange(GRID_W)
    col_start = np.clip(cols - NA_WIN_COLS // 2, 0, GRID_W - NA_WIN_COLS)
    col_idx = col_start[:, None] + np.arange(NA_WIN_COLS)[None, :]
    col_off = col_idx - cols[:, None] + (NA_WIN_COLS - 1)

    def row_step(args):
        r, q_row = args
        rs = jnp.clip(r - wr // 2, 0, rows - wr)
        k_rows = lax.dynamic_slice_in_dim(k_g, rs, wr, axis=2)
        v_rows = lax.dynamic_slice_in_dim(v_g, rs, wr, axis=2)
        k_win = jnp.take(k_rows, col_idx, axis=3)
        v_win = jnp.take(v_rows, col_idx, axis=3)
        s = jnp.einsum('bhcd,bhrckd->bhcrk', q_row, k_win).astype(jnp.float32) * scale
        row_off = rs + jnp.arange(wr) - r + (NA_WIN_ROWS - 1)
        bias = jnp.take(rpb[:, row_off], col_off, axis=2)
        s = s + bias.transpose(0, 2, 1, 3)[None].astype(jnp.float32)
        pr = jax.nn.softmax(s.reshape(B, H, GRID_W, wr * NA_WIN_COLS), axis=-1)
        pr = pr.reshape(B, H, GRID_W, wr, NA_WIN_COLS).astype(v.dtype)
        return jnp.einsum('bhcrk,bhrckd->bhcd', pr, v_win)

    out = lax.map(row_step, (jnp.arange(rows), q_g))
    return out.transpose(1, 0, 3, 2, 4).reshape(B, T, H * dh)


def retention_dir(q, k, v, gamma, include_diag):
    B, H, T, dk = q.shape
    dv = v.shape[-1]
    C = RET_CHUNK
    n = T // C
    qc = q.reshape(B, H, n, C, dk)
    kc = k.reshape(B, H, n, C, dk)
    vc = v.reshape(B, H, n, C, dv)
    log_g = jnp.log(gamma)
    i = np.arange(C)
    diff = i[:, None] - i[None, :]
    mask = (diff >= 0) if include_diag else (diff > 0)
    dpos = np.maximum(diff, 0).astype(np.float32)
    decay_in = jnp.where(mask[None], jnp.exp(log_g[:, None, None] * dpos[None]), 0.0)
    s = jnp.einsum('bhnid,bhnjd->bhnij', qc, kc) * decay_in[None, :, None]
    inner = jnp.einsum('bhnij,bhnje->bhnie', s, vc)
    zeta = jnp.exp(log_g[:, None] * (C - 1 - i).astype(np.float32))
    xi = jnp.exp(log_g[:, None] * (i + 1).astype(np.float32))
    chunk_decay = jnp.exp(log_g * C)
    kv = jnp.einsum('bhnjd,bhnje->nbhde', kc * zeta[None, :, None, :, None], vc)

    def body(S, kv_c):
        return S * chunk_decay[None, :, None, None] + kv_c, S

    S0 = jnp.zeros((B, H, dk, dv), kv.dtype)
    _, S_prev = lax.scan(body, S0, kv)
    cross = jnp.einsum('bhnid,nbhde->bhnie', qc, S_prev) * xi[None, :, None, :, None]
    return (inner + cross).reshape(B, H, T, dv)


def bidirectional_retention(q, k, v, g, decay_f, decay_b):
    B, T, H, dk = q.shape
    pos = jnp.arange(T, dtype=jnp.float32)
    qh = rotary(q.transpose(0, 2, 1, 3), pos)
    kh = rotary(k.transpose(0, 2, 1, 3), pos) * (dk ** -0.5)
    vh = v.reshape(B, T, H, RET_V_DIM).transpose(0, 2, 1, 3)
    gam_f = jax.nn.sigmoid(decay_f.astype(jnp.float32))
    gam_b = jax.nn.sigmoid(decay_b.astype(jnp.float32))
    fwd = retention_dir(qh, kh, vh, gam_f, True)
    bwd = jnp.flip(retention_dir(jnp.flip(qh, 2), jnp.flip(kh, 2), jnp.flip(vh, 2), gam_b, False), 2)
    o = (fwd + bwd).astype(jnp.float32)
    mu = jnp.mean(o, axis=-1, keepdims=True)
    var = jnp.mean(jnp.square(o - mu), axis=-1, keepdims=True)
    o = ((o - mu) * lax.rsqrt(var + GN_EPS)).astype(v.dtype)
    o = o.transpose(0, 2, 1, 3).reshape(B, T, H * RET_V_DIM)
    return jax.nn.silu(g) * o


def conv_glu_ffn(x, w_up, conv_w, conv_b, w_down):
    h = x @ w_up
    hp = jnp.pad(h, ((0, 0), (1, 1), (0, 0)))
    h = hp[:, :-2] * conv_w[0] + hp[:, 1:-1] * conv_w[1] + hp[:, 2:] * conv_w[2] + conv_b
    a, b = jnp.split(h, 2, axis=-1)
    return (jax.nn.gelu(a) * b) @ w_down


def setup_inputs(seed: int = 0) -> dict:
    key = jax.random.key(seed)
    ks = jax.random.split(key, 20)
    f32 = jnp.float32
    nrm = lambda k, shape: jax.random.normal(k, shape, f32)
    beta = DEEPNORM_BETA
    col_scale = np.ones((D_IN,), np.float32)
    col_scale[2 * NA_W:3 * NA_W] = beta
    v0 = 3 * NA_W + 2 * RET_QK_W
    col_scale[v0:v0 + RET_V_W] = beta
    gam = 1.0 - 2.0 ** (-5.0 - np.arange(RET_HEADS))
    base_logit = jnp.asarray(np.log(gam / (1.0 - gam)), f32)
    return {
        "x": nrm(ks[0], (BATCH, SEQ, D_MODEL)),
        "p": nrm(ks[1], (DEPTH, BATCH, SEQ, PLE_DIM)),
        "w_in": nrm(ks[2], (DEPTH, D_MODEL, D_IN)) * (D_MODEL ** -0.5) * jnp.asarray(col_scale),
        "na_rpb": 0.02 * nrm(ks[3], (DEPTH, NA_HEADS, 2 * NA_WIN_ROWS - 1, 2 * NA_WIN_COLS - 1)),
        "ret_decay_f": base_logit + 0.01 * nrm(ks[4], (DEPTH, RET_HEADS)),
        "ret_decay_b": base_logit + 0.01 * nrm(ks[5], (DEPTH, RET_HEADS)),
        "w_branch_a": nrm(ks[6], (DEPTH, NA_W, D_MODEL)) * (NA_W ** -0.5) * beta,
        "w_branch_b": nrm(ks[7], (DEPTH, RET_V_W, D_MODEL)) * (RET_V_W ** -0.5) * beta,
        "w_out": nrm(ks[8], (DEPTH, D_MODEL, D_MODEL)) * (D_MODEL ** -0.5) * beta,
        "ln1_g": 1.0 + 0.02 * nrm(ks[9], (DEPTH, D_MODEL)),
        "ln1_b": 0.02 * nrm(ks[10], (DEPTH, D_MODEL)),
        "w_up": nrm(ks[11], (DEPTH, D_MODEL, 2 * D_FF)) * (D_MODEL ** -0.5) * beta,
        "conv_w": nrm(ks[12], (DEPTH, CONV_W, 2 * D_FF)) * (CONV_W ** -0.5),
        "conv_b": 0.02 * nrm(ks[13], (DEPTH, 2 * D_FF)),
        "w_down": nrm(ks[14], (DEPTH, D_FF, D_MODEL)) * (D_FF ** -0.5) * beta,
        "w_ple_gate": nrm(ks[15], (DEPTH, D_MODEL, D_MODEL)) * (D_MODEL ** -0.5),
        "w_ple_proj": nrm(ks[16], (DEPTH, PLE_DIM, D_MODEL)) * (PLE_DIM ** -0.5) * beta,
        "ln2_g": 1.0 + 0.02 * nrm(ks[17], (DEPTH, D_MODEL)),
        "ln2_b": 0.02 * nrm(ks[18], (DEPTH, D_MODEL)),
    }


def reference(x, p, w_in, na_rpb, ret_decay_f, ret_decay_b, w_branch_a, w_branch_b, w_out,
              ln1_g, ln1_b, w_up, conv_w, conv_b, w_down, w_ple_gate, w_ple_proj, ln2_g, ln2_b):
    B, T, _ = x.shape
    for i in range(DEPTH):
        proj = x @ w_in[i]
        q_na, k_na, v_na, q_r, k_r, v_r, g_r, gate_a, gate_b = jnp.split(proj, IN_SPLITS, axis=-1)
        ya = neighbourhood_attention(q_na.reshape(B, T, NA_HEADS, NA_HEAD_DIM),
                                     k_na.reshape(B, T, NA_HEADS, NA_HEAD_DIM),
                                     v_na.reshape(B, T, NA_HEADS, NA_HEAD_DIM), na_rpb[i])
        yb = bidirectional_retention(q_r.reshape(B, T, RET_HEADS, RET_QK_DIM),
                                     k_r.reshape(B, T, RET_HEADS, RET_QK_DIM),
                                     v_r, g_r, ret_decay_f[i], ret_decay_b[i])
        merged = jax.nn.sigmoid(gate_a) * (ya @ w_branch_a[i]) + jax.nn.sigmoid(gate_b) * (yb @ w_branch_b[i])
        y = merged @ w_out[i]
        x = layer_norm(DEEPNORM_ALPHA * x + y, ln1_g[i], ln1_b[i])
        ffn = conv_glu_ffn(x, w_up[i], conv_w[i], conv_b[i], w_down[i])
        ple = jax.nn.sigmoid(x @ w_ple_gate[i]) * (p[i] @ w_ple_proj[i])
        x = layer_norm(DEEPNORM_ALPHA * x + ffn + ple, ln2_g[i], ln2_b[i])
    return x
```

```cpp
#include <hip/hip_runtime.h>
#include <hip/hip_cooperative_groups.h>
#include <cstdio>
#include <cstdint>
namespace cg = cooperative_groups;
namespace pg8 {
#define PG8_LAS __attribute__((address_space(3)))
typedef unsigned short bf16_t;
typedef short bf16x8 __attribute__((ext_vector_type(8)));
typedef float f32x4 __attribute__((ext_vector_type(4)));
typedef unsigned u32x4 __attribute__((ext_vector_type(4)));
constexpr int BM = 256, BK = 64, HALF = 128, HTB = HALF * BK * 2  , STAGE_BYTES = 8 * HTB, NXCD = 8, WGM = 8;

__host__ __device__ __forceinline__ int lds_byte(int r, int c) { const int st = (r >> 4) * 2 + (c >> 5), rr = r & 15, cc = c & 31, ob = rr * 64 + cc * 2; return st * 1024 + (ob ^ (((ob >> 9) & 1) << 5)); }
__host__ __device__ __forceinline__ void stage_rc(int b, int& R, int& C) { const int st = b / 1024, sb = b % 1024, swz = sb ^ (((sb >> 9) & 1) << 5); R = (st >> 1) * 16 + swz / 64; C = (st & 1) * 32 + (swz % 64) / 2; }
__host__ __device__ __forceinline__ int perm32(int rho) { const int n = rho >> 4, i = rho & 15; return 8 * (i >> 2) + 4 * n + (i & 3); }

struct Unit { int pm, pn; };
struct Gemm { const bf16_t* A; const bf16_t* Bt; int M, N, K; };

struct StaticOrder {
    int nM, nN, nwg, G, c;
    __host__ __device__ void init(int M, int N, int G_, int c_) { nM = M / BM; nN = N / BM; nwg = nM * nN; G = G_; c = c_; }
    __host__ __device__ bool next(int i, Unit& u) const {
        const long L = (long)i * G + c; if (L >= nwg) return false;
        int wgid = (int)L; { const int q = nwg / NXCD, r = nwg % NXCD, xcd = wgid % NXCD, off = wgid / NXCD; wgid = (xcd < r ? xcd * (q + 1) : r * (q + 1) + (xcd - r) * q) + off; }
        const int nig = WGM * nN, gid = wgid / nig, fm = gid * WGM, gsz = (nM - fm) < WGM ? (nM - fm) : WGM;
        u.pm = fm + ((wgid % nig) % gsz); u.pn = (wgid % nig) / gsz; return true;
    }
    __device__ __forceinline__ void a_ready(const Unit&) const {}
    __device__ __forceinline__ void done(const Unit&) const {}
};

__device__ __forceinline__ unsigned cvt_pk_bf16(float lo, float hi) { unsigned r; asm volatile("v_cvt_pk_bf16_f32 %0, %1, %2" : "=v"(r) : "v"(lo), "v"(hi)); return r; }
template <class Epi, class Sched, bool ALIGN_EPI = false, bool SP2 = false>
__device__ __forceinline__ void gemm_phase(PG8_LAS unsigned char* lds, const Gemm g, const Sched& S, const Epi& E) {
    int tid_raw_ = threadIdx.x; asm volatile("" : "+v"(tid_raw_)); const int tid = tid_raw_, wid = __builtin_amdgcn_readfirstlane(tid >> 6), lane = tid & 63, wr = wid >> 2, wc = wid & 3, fr = lane & 15, fq = lane >> 4;
    const int K = g.K, nt = K / BK;
    unsigned voffA[2], voffB[2];
#pragma unroll
    for (int i = 0; i < 2; ++i) { int R, C; stage_rc(tid * 16 + i * 8192, R, C); const int Rb = Epi::PERM ? ((R & ~31) + perm32(R & 31)) : R;
        voffA[i] = (unsigned)(R * K + C) * 2u; voffB[i] = (unsigned)(Rb * K + C) * 2u; }
    const size_t kstep = (size_t)(BK * 2);
    const size_t hstep = (size_t)HALF * K * 2;
    const size_t tstep = 2 * hstep;
    const unsigned ldsw = (unsigned)wid * 1024u;
    const int aoff = lds_byte(wr * 64 + fr, fq * 8), boff = lds_byte(wc * 32 + fr, fq * 8);
#define PG8_SA(b, h) (((b) * 2 + (h)) * HTB)
#define PG8_SB(b, h) ((4 + (b) * 2 + (h)) * HTB)
#define PG8_STAGE(bufoff, gbase, voff) do { _Pragma("unroll") for (int _i = 0; _i < 2; ++_i) \
        __builtin_amdgcn_global_load_lds((const unsigned*)((const char*)(gbase) + (voff)[_i]), (PG8_LAS unsigned*)(lds + (bufoff) + ldsw + _i * 8192), 16, 0, 0); } while (0)
#define PG8_LDA(dst, b, h) do { _Pragma("unroll") for (int m = 0; m < 4; ++m) _Pragma("unroll") for (int k = 0; k < 2; ++k) dst[m][k] = *(const PG8_LAS bf16x8*)(lds + PG8_SA(b, h) + aoff + m * 2048 + k * 1024); } while (0)
#define PG8_LDB(dst, b, h) do { _Pragma("unroll") for (int n = 0; n < 2; ++n) _Pragma("unroll") for (int k = 0; k < 2; ++k) dst[n][k] = *(const PG8_LAS bf16x8*)(lds + PG8_SB(b, h) + boff + n * 2048 + k * 1024); } while (0)
#define PG8_MMA(ai, bj, At, Bt) do { __builtin_amdgcn_s_setprio(1); _Pragma("unroll") for (int m = 0; m < 4; ++m) _Pragma("unroll") for (int n = 0; n < 2; ++n) _Pragma("unroll") for (int k = 0; k < 2; ++k) \
        acc[ai][bj][m][n] = __builtin_amdgcn_mfma_f32_16x16x32_bf16(Bt[n][k], At[m][k], acc[ai][bj][m][n], 0, 0, 0); __builtin_amdgcn_s_setprio(0); } while (0)
#define PG8_WAIT_V(n) asm volatile("s_waitcnt vmcnt(" #n ")" ::: "memory")
#define PG8_WAIT_L(n) asm volatile("s_waitcnt lgkmcnt(" #n ")" ::: "memory")
#define PG8_BAR __builtin_amdgcn_s_barrier()
#define PG8_SCHED __builtin_amdgcn_sched_barrier(0)
    Unit cur, nxt; int ui = 0;
    if (!S.next(0, cur)) return;
    f32x4 acc[2][2][4][2];
#pragma unroll
    for (int a = 0; a < 2; ++a)
#pragma unroll
        for (int b = 0; b < 2; ++b)
#pragma unroll
            for (int m = 0; m < 4; ++m)
#pragma unroll
                for (int n = 0; n < 2; ++n) acc[a][b][m][n] = (f32x4){0.f, 0.f, 0.f, 0.f};
    bf16x8 At[4][2], B0[2][2], B1[2][2];
    const char* cA = (const char*)g.A + (size_t)cur.pm * tstep; const char* cB = (const char*)g.Bt + (size_t)cur.pn * tstep;
    S.a_ready(cur);
    if constexpr (SP2) {
        PG8_STAGE(PG8_SB(0, 0), cB, voffB); PG8_STAGE(PG8_SB(0, 1), cB + hstep, voffB); PG8_STAGE(PG8_SA(0, 0), cA, voffA); PG8_STAGE(PG8_SA(0, 1), cA + hstep, voffA);
        if (wr == 1) PG8_BAR;
        PG8_WAIT_V(2); PG8_BAR;
        PG8_STAGE(PG8_SB(1, 0), cB + kstep, voffB); PG8_STAGE(PG8_SA(1, 0), cA + kstep, voffA); PG8_STAGE(PG8_SB(1, 1), cB + hstep + kstep, voffB);
        PG8_WAIT_V(6); PG8_BAR;
    } else {
        PG8_STAGE(PG8_SB(0, 0), cB, voffB); PG8_STAGE(PG8_SA(0, 0), cA, voffA); PG8_STAGE(PG8_SB(0, 1), cB + hstep, voffB); PG8_STAGE(PG8_SA(0, 1), cA + hstep, voffA);
        if (wr == 1) PG8_BAR;
        PG8_WAIT_V(4); PG8_BAR;
        PG8_STAGE(PG8_SB(1, 0), cB + kstep, voffB); PG8_STAGE(PG8_SA(1, 0), cA + kstep, voffA); PG8_STAGE(PG8_SB(1, 1), cB + hstep + kstep, voffB);
        PG8_WAIT_V(6); PG8_BAR;
    }
    for (;;) {
        const bool has_next = S.next(ui + 1, nxt);
        const char* nA = has_next ? (const char*)g.A + (size_t)nxt.pm * tstep : cA; const char* nB = has_next ? (const char*)g.Bt + (size_t)nxt.pn * tstep : cB;
        for (int t = 0; t < nt; t += 2) {
            const bool last = (t == nt - 2);
            const char* a1 = cA + (size_t)(t + 1) * kstep;
            const char* a2 = last ? nA : cA + (size_t)(t + 2) * kstep; const char* b2 = last ? nB : cB + (size_t)(t + 2) * kstep;
            const char* a3 = a2 + kstep; const char* b3 = b2 + kstep;
            if (last && has_next) S.a_ready(nxt);
            if constexpr (SP2) {
            PG8_LDB(B0, 0, 0); PG8_LDB(B1, 0, 1); PG8_SCHED; PG8_LDA(At, 0, 0); PG8_STAGE(PG8_SA(1, 1), a1 + hstep, voffA);
            PG8_WAIT_V(8); PG8_WAIT_L(0); PG8_BAR; PG8_MMA(0, 0, At, B0); PG8_MMA(0, 1, At, B1); PG8_BAR; PG8_SCHED;
            PG8_LDA(At, 0, 1); PG8_STAGE(PG8_SB(0, 0), b2, voffB); PG8_STAGE(PG8_SB(0, 1), b2 + hstep, voffB); PG8_STAGE(PG8_SA(0, 0), a2, voffA);
            PG8_WAIT_V(8); PG8_WAIT_L(0); PG8_BAR; PG8_MMA(1, 0, At, B0); PG8_MMA(1, 1, At, B1); PG8_BAR; PG8_SCHED;
            PG8_LDB(B0, 1, 0); PG8_LDB(B1, 1, 1); PG8_SCHED; PG8_LDA(At, 1, 0); PG8_STAGE(PG8_SA(0, 1), a2 + hstep, voffA);
            PG8_WAIT_V(8); PG8_WAIT_L(0); PG8_BAR; PG8_MMA(0, 0, At, B0); PG8_MMA(0, 1, At, B1); PG8_BAR; PG8_SCHED;
            PG8_LDA(At, 1, 1); PG8_STAGE(PG8_SB(1, 0), b3, voffB); PG8_STAGE(PG8_SB(1, 1), b3 + hstep, voffB); PG8_STAGE(PG8_SA(1, 0), a3, voffA);
            PG8_WAIT_V(8); PG8_WAIT_L(0); PG8_BAR; PG8_MMA(1, 0, At, B0); PG8_MMA(1, 1, At, B1); PG8_BAR; PG8_SCHED;
            } else {
            PG8_LDB(B0, 0, 0); PG8_SCHED; PG8_LDA(At, 0, 0); PG8_STAGE(PG8_SA(1, 1), a1 + hstep, voffA);
            PG8_WAIT_L(8); PG8_BAR; PG8_WAIT_L(0); PG8_MMA(0, 0, At, B0); PG8_BAR; PG8_SCHED;
            PG8_LDB(B1, 0, 1); PG8_STAGE(PG8_SB(0, 0), b2, voffB);
            PG8_BAR; PG8_WAIT_L(0); PG8_MMA(0, 1, At, B1); PG8_BAR;
            PG8_LDA(At, 0, 1); PG8_STAGE(PG8_SA(0, 0), a2, voffA);
            PG8_BAR; PG8_WAIT_L(0); PG8_MMA(1, 0, At, B0); PG8_BAR; PG8_SCHED;
            PG8_STAGE(PG8_SB(0, 1), b2 + hstep, voffB);
            PG8_WAIT_V(6); PG8_BAR; PG8_MMA(1, 1, At, B1); PG8_BAR;
            PG8_LDB(B0, 1, 0); PG8_SCHED; PG8_LDA(At, 1, 0); PG8_STAGE(PG8_SA(0, 1), a2 + hstep, voffA);
            PG8_WAIT_L(8); PG8_BAR; PG8_WAIT_L(0); PG8_MMA(0, 0, At, B0); PG8_BAR; PG8_SCHED;
            PG8_LDB(B1, 1, 1); PG8_STAGE(PG8_SB(1, 0), b3, voffB);
            PG8_BAR; PG8_WAIT_L(0); PG8_MMA(0, 1, At, B1); PG8_BAR;
            PG8_LDA(At, 1, 1); PG8_STAGE(PG8_SA(1, 0), a3, voffA);
            PG8_BAR; PG8_WAIT_L(0); PG8_MMA(1, 0, At, B0); PG8_BAR; PG8_SCHED;
            PG8_STAGE(PG8_SB(1, 1), b3 + hstep, voffB);
            PG8_WAIT_V(6); PG8_BAR; PG8_MMA(1, 1, At, B1); PG8_BAR;
            }
        }
        if constexpr (ALIGN_EPI) { if (wr == 0) PG8_BAR; }
        if constexpr (!Epi::AFTER_DRAIN) { E(acc, cur, wr, wc, fr, fq); S.done(cur); }
        if (!has_next) break;
#pragma unroll
        for (int a = 0; a < 2; ++a)
#pragma unroll
            for (int b = 0; b < 2; ++b)
#pragma unroll
                for (int m = 0; m < 4; ++m)
#pragma unroll
                    for (int n = 0; n < 2; ++n) acc[a][b][m][n] = (f32x4){0.f, 0.f, 0.f, 0.f};
        cur = nxt; cA = nA; cB = nB; ++ui;
        if constexpr (ALIGN_EPI) { if (wr == 1) PG8_BAR; }
    }
    PG8_WAIT_V(0);
    if constexpr (!ALIGN_EPI) { if (wr == 0) PG8_BAR; }
    PG8_BAR;
    if constexpr (Epi::AFTER_DRAIN) { E.fused(acc, cur, wr, wc, fr, fq, lds, wid, lane); S.done(cur); }
#undef PG8_SA
#undef PG8_SB
#undef PG8_STAGE
#undef PG8_LDA
#undef PG8_LDB
#undef PG8_MMA
#undef PG8_WAIT_V
#undef PG8_WAIT_L
#undef PG8_BAR
#undef PG8_SCHED
}
}

using namespace pg8;
#define LAS __attribute__((address_space(3)))
typedef unsigned u32x2 __attribute__((ext_vector_type(2)));
constexpr int MTOK = 32768, DM = 1024, SEQ = 8192, NLAYER = 4;
constexpr float ALPHA = 1.681792830507429f;
constexpr float LN_EPS = 1e-5f, GN_EPS = 1e-6f;
constexpr size_t MiB = 1u << 20;
constexpr size_t WS_COS = 1 * MiB, WS_SIN = 3 * MiB, WS_W = 6 * MiB, WS_XB = 44 * MiB, WS_QNA = 108 * MiB, WS_KNA = 140 * MiB, WS_VTNA = 172 * MiB,
                 WS_KT = 204 * MiB, WS_QR = 268 * MiB, WS_KR = 300 * MiB, WS_VTR = 332 * MiB, WS_GR = 396 * MiB, WS_ST = 460 * MiB, WS_PB = 524 * MiB,
                 WS_GA = 140 * MiB, WS_GB = 204 * MiB, WS_MRG = 268 * MiB, WS_SG = 108 * MiB, WS_H = 172 * MiB, WS_U = 364 * MiB, WS_END = 540 * MiB;
constexpr size_t W_IN = 0, W_A = W_IN + (size_t)6656 * 1024, W_B = W_A + (size_t)1024 * 512, W_O = W_B + (size_t)1024 * 1024, W_UP = W_O + (size_t)1024 * 1024,
                 W_D1 = W_UP + (size_t)5632 * 1024, W_D2 = W_D1 + (size_t)1024 * 1536, W_PG = W_D2 + (size_t)1024 * 1280, W_PP = W_PG + (size_t)1024 * 1024, W_TOTAL = W_PP + (size_t)1024 * 256;
static_assert(W_TOTAL * 2 <= 38 * MiB, "weights fit");
constexpr int FF1 = 1536, FF2 = 1280;

__device__ __forceinline__ float bflo(unsigned w) { return __uint_as_float(w << 16); }
__device__ __forceinline__ float bfhi(unsigned w) { return __uint_as_float(w & 0xffff0000u); }
__device__ __forceinline__ float sigm(float x) { return 1.f / (1.f + __expf(-x)); }
__device__ __forceinline__ float gelu_tanh(float x) { const float y = 0.7978845608028654f * (x + 0.044715f * x * x * x); const float t = 1.f - 2.f / (__expf(2.f * y) + 1.f); return 0.5f * x * (1.f + t); }
__device__ __forceinline__ bf16x8 mk8(unsigned a, unsigned b, unsigned c, unsigned d) { u32x4 w = {a, b, c, d}; return __builtin_bit_cast(bf16x8, w); }
__device__ __forceinline__ bf16x8 scale8(bf16x8 v, float s) { u32x4 w = __builtin_bit_cast(u32x4, v);
    return mk8(cvt_pk_bf16(bflo(w.x) * s, bfhi(w.x) * s), cvt_pk_bf16(bflo(w.y) * s, bfhi(w.y) * s), cvt_pk_bf16(bflo(w.z) * s, bfhi(w.z) * s), cvt_pk_bf16(bflo(w.w) * s, bfhi(w.w) * s)); }
#define MFMA16(a, b, c) __builtin_amdgcn_mfma_f32_16x16x32_bf16((a), (b), (c), 0, 0, 0)

template <int ACT> struct EpiBf {
    static constexpr bool PERM = true, AFTER_DRAIN = false;
    bf16_t* base0; bf16_t* base1; int nsplit; int ld;
    __device__ __forceinline__ void operator()(const f32x4 (&acc)[2][2][4][2], const Unit& u, int wr, int wc, int fr, int fq) const {
        bf16_t* base = (u.pn < nsplit) ? base0 + u.pn * 256 : base1 + (u.pn - nsplit) * 256;
        const int row0 = u.pm * 256 + wr * 64 + fr, col0 = wc * 32 + 8 * fq;
#pragma unroll
        for (int ai = 0; ai < 2; ++ai)
#pragma unroll
            for (int m = 0; m < 4; ++m) { bf16_t* rowp = base + (size_t)(row0 + ai * HALF + m * 16) * ld + col0;
#pragma unroll
                for (int bj = 0; bj < 2; ++bj) { f32x4 v0 = acc[ai][bj][m][0], v1 = acc[ai][bj][m][1];
                    if (ACT == 2) { v0 = (f32x4){sigm(v0[0]), sigm(v0[1]), sigm(v0[2]), sigm(v0[3])}; v1 = (f32x4){sigm(v1[0]), sigm(v1[1]), sigm(v1[2]), sigm(v1[3])}; }
                    u32x4 w; w.x = cvt_pk_bf16(v0[0], v0[1]); w.y = cvt_pk_bf16(v0[2], v0[3]); w.z = cvt_pk_bf16(v1[0], v1[1]); w.w = cvt_pk_bf16(v1[2], v1[3]);
                    *(u32x4*)(rowp + bj * HALF) = w; } }
    }
};
struct EpiVT {
    static constexpr bool PERM = true, AFTER_DRAIN = false;
    bf16_t* vtna; bf16_t* vtr;
    __device__ __forceinline__ void operator()(const f32x4 (&acc)[2][2][4][2], const Unit& u, int wr, int wc, int fr, int fq) const {
        bf16_t* base = (u.pm < 2) ? vtna + (size_t)(u.pm * 256) * MTOK : vtr + (size_t)((u.pm - 2) * 256) * MTOK;
        const int row0 = wr * 64 + fr, col0 = u.pn * 256 + wc * 32 + 8 * fq;
#pragma unroll
        for (int ai = 0; ai < 2; ++ai)
#pragma unroll
            for (int m = 0; m < 4; ++m) { bf16_t* rowp = base + (size_t)(row0 + ai * HALF + m * 16) * MTOK + col0;
#pragma unroll
                for (int bj = 0; bj < 2; ++bj) { const f32x4 v0 = acc[ai][bj][m][0], v1 = acc[ai][bj][m][1];
                    u32x4 w; w.x = cvt_pk_bf16(v0[0], v0[1]); w.y = cvt_pk_bf16(v0[2], v0[3]); w.z = cvt_pk_bf16(v1[0], v1[1]); w.w = cvt_pk_bf16(v1[2], v1[3]);
                    *(u32x4*)(rowp + bj * HALF) = w; } }
    }
};
struct EpiProj {
    static constexpr bool PERM = true, AFTER_DRAIN = false;
    bf16_t *qna, *kna, *qr, *kr, *kt, *gr; const float* cosT; const float* sinT;
    __device__ __forceinline__ void operator()(const f32x4 (&acc)[2][2][4][2], const Unit& u, int wr, int wc, int fr, int fq) const {
        const int pn = u.pn, row0 = u.pm * 256 + wr * 64 + fr;
        if (pn < 4 || pn >= 8) {
            bf16_t* base; int ld; float sc = 1.f;
            if (pn < 2) { base = qna + pn * 256; ld = 512; sc = 0.125f; } else if (pn < 4) { base = kna + (pn - 2) * 256; ld = 512; } else { base = gr + (pn - 8) * 256; ld = 1024; }
            const int col0 = wc * 32 + 8 * fq;
#pragma unroll
            for (int ai = 0; ai < 2; ++ai)
#pragma unroll
                for (int m = 0; m < 4; ++m) { bf16_t* rowp = base + (size_t)(row0 + ai * HALF + m * 16) * ld + col0;
#pragma unroll
                    for (int bj = 0; bj < 2; ++bj) { const f32x4 v0 = acc[ai][bj][m][0] * sc, v1 = acc[ai][bj][m][1] * sc;
                        u32x4 w; w.x = cvt_pk_bf16(v0[0], v0[1]); w.y = cvt_pk_bf16(v0[2], v0[3]); w.z = cvt_pk_bf16(v1[0], v1[1]); w.w = cvt_pk_bf16(v1[2], v1[3]);
                        *(u32x4*)(rowp + bj * HALF) = w; } }
        } else {
            const bool isk = pn >= 6; bf16_t* base = isk ? kr : qr; const int hb = (isk ? pn - 6 : pn - 4) * 2;
            const float sc = isk ? 0.08838834764831845f : 1.f;
            const int i4 = 4 * (4 * wc + fq);
#pragma unroll
            for (int ai = 0; ai < 2; ++ai)
#pragma unroll
                for (int m = 0; m < 4; ++m) { const int row = row0 + ai * HALF + m * 16, t = row & (SEQ - 1);
                    const f32x4 c = *(const f32x4*)(cosT + t * 64 + i4), s = *(const f32x4*)(sinT + t * 64 + i4);
#pragma unroll
                    for (int bj = 0; bj < 2; ++bj) { const int head = hb + bj; const f32x4 x1 = acc[ai][bj][m][0], x2 = acc[ai][bj][m][1];
                        const f32x4 o1 = (x1 * c - x2 * s) * sc, o2 = (x2 * c + x1 * s) * sc;
                        u32x2 w1, w2; w1.x = cvt_pk_bf16(o1[0], o1[1]); w1.y = cvt_pk_bf16(o1[2], o1[3]); w2.x = cvt_pk_bf16(o2[0], o2[1]); w2.y = cvt_pk_bf16(o2[2], o2[3]);
                        bf16_t* p = base + (size_t)row * 512 + head * 128 + i4;
                        *(u32x2*)p = w1; *(u32x2*)(p + 64) = w2;
                        if (isk) { bf16_t* q = kt + (size_t)(head * 128 + i4) * MTOK + row;
                            q[0] = (bf16_t)(w1.x & 0xffffu); q[(size_t)MTOK] = (bf16_t)(w1.x >> 16); q[(size_t)2 * MTOK] = (bf16_t)(w1.y & 0xffffu); q[(size_t)3 * MTOK] = (bf16_t)(w1.y >> 16);
                            bf16_t* q2 = q + (size_t)64 * MTOK;
                            q2[0] = (bf16_t)(w2.x & 0xffffu); q2[(size_t)MTOK] = (bf16_t)(w2.x >> 16); q2[(size_t)2 * MTOK] = (bf16_t)(w2.y & 0xffffu); q2[(size_t)3 * MTOK] = (bf16_t)(w2.y >> 16); } } }
        }
    }
};
template <int MODE> struct EpiMerge {
    static constexpr bool PERM = true, AFTER_DRAIN = false;
    bf16_t* mrg; const bf16_t* gate;
    __device__ __forceinline__ void operator()(const f32x4 (&acc)[2][2][4][2], const Unit& u, int wr, int wc, int fr, int fq) const {
        const int row0 = u.pm * 256 + wr * 64 + fr, col0 = u.pn * 256 + wc * 32 + 8 * fq;
#pragma unroll
        for (int ai = 0; ai < 2; ++ai)
#pragma unroll
            for (int m = 0; m < 4; ++m) { const size_t off = (size_t)(row0 + ai * HALF + m * 16) * 1024 + col0;
#pragma unroll
                for (int bj = 0; bj < 2; ++bj) { const f32x4 v0 = acc[ai][bj][m][0], v1 = acc[ai][bj][m][1];
                    const u32x4 g = *(const u32x4*)(gate + off + bj * HALF);
                    float r0 = bflo(g.x) * v0[0], r1 = bfhi(g.x) * v0[1], r2 = bflo(g.y) * v0[2], r3 = bfhi(g.y) * v0[3], r4 = bflo(g.z) * v1[0], r5 = bfhi(g.z) * v1[1], r6 = bflo(g.w) * v1[2], r7 = bfhi(g.w) * v1[3];
                    if (MODE == 1) { const u32x4 p = *(const u32x4*)(mrg + off + bj * HALF);
                        r0 += bflo(p.x); r1 += bfhi(p.x); r2 += bflo(p.y); r3 += bfhi(p.y); r4 += bflo(p.z); r5 += bfhi(p.z); r6 += bflo(p.w); r7 += bfhi(p.w); }
                    u32x4 w; w.x = cvt_pk_bf16(r0, r1); w.y = cvt_pk_bf16(r2, r3); w.z = cvt_pk_bf16(r4, r5); w.w = cvt_pk_bf16(r6, r7);
                    *(u32x4*)(mrg + off + bj * HALF) = w; } }
    }
};
template <int MODE> struct EpiF32 {
    static constexpr bool PERM = false, AFTER_DRAIN = false;
    float* out; const float* res; const bf16_t* sg;
    __device__ __forceinline__ void operator()(const f32x4 (&acc)[2][2][4][2], const Unit& u, int wr, int wc, int fr, int fq) const {
        const int row0 = u.pm * 256 + wr * 64 + fr, col0 = u.pn * 256 + wc * 32 + 4 * fq;
#pragma unroll
        for (int ai = 0; ai < 2; ++ai)
#pragma unroll
            for (int m = 0; m < 4; ++m) { const size_t off = (size_t)(row0 + ai * HALF + m * 16) * 1024 + col0;
#pragma unroll
                for (int bj = 0; bj < 2; ++bj)
#pragma unroll
                    for (int n = 0; n < 2; ++n) { const size_t o = off + bj * HALF + n * 16; const f32x4 a = acc[ai][bj][m][n]; f32x4 r;
                        if (MODE == 0) { r = *(const f32x4*)(res + o) * ALPHA + a; }
                        else if (MODE == 1) { const u32x2 g = *(const u32x2*)(sg + o); const f32x4 gv = {bflo(g.x), bfhi(g.x), bflo(g.y), bfhi(g.y)}; r = *(const f32x4*)(out + o) * ALPHA + gv * a; }
                        else { r = *(const f32x4*)(out + o) + a; }
                        *(f32x4*)(out + o) = r; } }
    }
};

__device__ __forceinline__ float wave_sum(float v) {
#pragma unroll
    for (int o = 1; o < 64; o <<= 1) v += __shfl_xor(v, o);
    return v;
}
__device__ __forceinline__ int rotp(int x) { const int head = x >> 7, d = x & 127, i = (d & 63) >> 2, e = d & 3; return head * 128 + 8 * i + ((d >> 6) << 2) + e; }
__device__ __forceinline__ int map_win(int n) {
    if (n < 1024) return n;
    if (n < 1536) return 3072 + (n - 1024);
    if (n < 2048) return 1024 + rotp(n - 1536);
    if (n < 2560) return 1536 + rotp(n - 2048);
    if (n < 3584) return 3584 + (n - 2560);
    if (n < 4608) return 2048 + (n - 3584);
    return n;
}
__device__ __forceinline__ int map_wup(int n) {
    const bool a = n < 2816; const int j = a ? n : n - 2816;
    if (j < FF1) return (a ? 0 : FF1) + j;
    return 2 * FF1 + (a ? 0 : FF2) + (j - FF1);
}
template <int MAP> __device__ __forceinline__ void transpose_item(const float* W, int N, int k0, int n0, bf16_t* dst, int dstK, int kbase, LAS float* scr, int lane) {
#pragma unroll 8
    for (int i = 0; i < 32; ++i) { const int kk = 2 * i + (lane >> 5); scr[kk * 33 + (lane & 31)] = W[(size_t)(k0 + kk) * N + n0 + (lane & 31)]; }
    asm volatile("s_waitcnt lgkmcnt(0)" ::: "memory");
    const int c = lane & 7;
#pragma unroll
    for (int j = 0; j < 4; ++j) { const int n = (lane >> 3) + 8 * j; const LAS float* s = scr + (8 * c) * 33 + n;
        u32x4 o; o.x = cvt_pk_bf16(s[0 * 33], s[1 * 33]); o.y = cvt_pk_bf16(s[2 * 33], s[3 * 33]); o.z = cvt_pk_bf16(s[4 * 33], s[5 * 33]); o.w = cvt_pk_bf16(s[6 * 33], s[7 * 33]);
        const int sn = n0 + n; const int dr = (MAP == 1) ? map_win(sn) : (MAP == 2) ? map_wup(sn) : sn;
        *(u32x4*)(dst + (size_t)dr * dstK + (k0 - kbase) + 8 * c) = o; }
    asm volatile("s_waitcnt lgkmcnt(0)" ::: "memory");
}
struct In { const float* p[19]; };
__device__ __forceinline__ void convert_layer(const In& in, int layer, bf16_t* Wb, bf16_t* PB, LAS float* scr, int gw, int NGW, int lane) {
    const float* w_in = in.p[2] + (size_t)layer * 1024 * 6656; const float* w_a = in.p[6] + (size_t)layer * 512 * 1024; const float* w_b = in.p[7] + (size_t)layer * 1024 * 1024;
    const float* w_o = in.p[8] + (size_t)layer * 1024 * 1024; const float* w_up = in.p[11] + (size_t)layer * 1024 * 5632; const float* w_dn = in.p[14] + (size_t)layer * 2816 * 1024;
    const float* w_pg = in.p[15] + (size_t)layer * 1024 * 1024; const float* w_pp = in.p[16] + (size_t)layer * 256 * 1024;
    constexpr int I_IN = 16 * 208, I_A = 8 * 32, I_B = 16 * 32, I_O = 16 * 32, I_UP = 16 * 176, I_D1 = 24 * 32, I_D2 = 20 * 32, I_PG = 16 * 32, I_PP = 4 * 32;
    constexpr int NIT = I_IN + I_A + I_B + I_O + I_UP + I_D1 + I_D2 + I_PG + I_PP;
    for (int it = gw; it < NIT; it += NGW) {
        int r = it;
        if (r < I_IN) { transpose_item<1>(w_in, 6656, 64 * (r / 208), 32 * (r % 208), Wb + W_IN, 1024, 0, scr, lane); continue; } r -= I_IN;
        if (r < I_A) { transpose_item<0>(w_a, 1024, 64 * (r / 32), 32 * (r % 32), Wb + W_A, 512, 0, scr, lane); continue; } r -= I_A;
        if (r < I_B) { transpose_item<0>(w_b, 1024, 64 * (r / 32), 32 * (r % 32), Wb + W_B, 1024, 0, scr, lane); continue; } r -= I_B;
        if (r < I_O) { transpose_item<0>(w_o, 1024, 64 * (r / 32), 32 * (r % 32), Wb + W_O, 1024, 0, scr, lane); continue; } r -= I_O;
        if (r < I_UP) { transpose_item<2>(w_up, 5632, 64 * (r / 176), 32 * (r % 176), Wb + W_UP, 1024, 0, scr, lane); continue; } r -= I_UP;
        if (r < I_D1) { transpose_item<0>(w_dn, 1024, 64 * (r / 32), 32 * (r % 32), Wb + W_D1, FF1, 0, scr, lane); continue; } r -= I_D1;
        if (r < I_D2) { transpose_item<0>(w_dn, 1024, FF1 + 64 * (r / 32), 32 * (r % 32), Wb + W_D2, FF2, FF1, scr, lane); continue; } r -= I_D2;
        if (r < I_PG) { transpose_item<0>(w_pg, 1024, 64 * (r / 32), 32 * (r % 32), Wb + W_PG, 1024, 0, scr, lane); continue; } r -= I_PG;
        transpose_item<0>(w_pp, 1024, 64 * (r / 32), 32 * (r % 32), Wb + W_PP, 256, 0, scr, lane);
    }
    const float* ps = in.p[1] + (size_t)layer * MTOK * 256;
    for (int i = gw; i < MTOK * 256 / 512; i += NGW) { const size_t e = (size_t)i * 512 + lane * 8; const f32x4 a = *(const f32x4*)(ps + e), b = *(const f32x4*)(ps + e + 4);
        u32x4 w; w.x = cvt_pk_bf16(a[0], a[1]); w.y = cvt_pk_bf16(a[2], a[3]); w.z = cvt_pk_bf16(b[0], b[1]); w.w = cvt_pk_bf16(b[2], b[3]); *(u32x4*)(PB + e) = w; }
}
__device__ __forceinline__ void ln_row(const float* src, float* dst, bf16_t* xb, const float* g, const float* b, int lane) {
    const f32x4* xr = (const f32x4*)src + lane; f32x4 v[4]; float s = 0.f;
#pragma unroll
    for (int j = 0; j < 4; ++j) { v[j] = xr[64 * j]; s += (v[j][0] + v[j][1]) + (v[j][2] + v[j][3]); }
    const float mean = wave_sum(s) * (1.f / DM); float s2 = 0.f;
#pragma unroll
    for (int j = 0; j < 4; ++j) { v[j] = v[j] - mean; s2 += (v[j][0] * v[j][0] + v[j][1] * v[j][1]) + (v[j][2] * v[j][2] + v[j][3] * v[j][3]); }
    const float rstd = 1.f / sqrtf(wave_sum(s2) * (1.f / DM) + LN_EPS);
#pragma unroll
    for (int j = 0; j < 4; ++j) { const f32x4 gg = ((const f32x4*)g)[lane + 64 * j], bb = ((const f32x4*)b)[lane + 64 * j]; const f32x4 o = v[j] * rstd * gg + bb;
        ((f32x4*)dst)[lane + 64 * j] = o; u32x2 w; w.x = cvt_pk_bf16(o[0], o[1]); w.y = cvt_pk_bf16(o[2], o[3]); ((u32x2*)xb)[lane + 64 * j] = w; }
}

__device__ __forceinline__ void na_phase(bf16_t* QNA, const bf16_t* KNA, const bf16_t* VT, const float* rpb, LAS float* ldsf, int tid, int wave, int lane, int bid) {
    for (int i = tid; i < 8 * 465; i += 512) ldsf[i] = rpb[i];
    __syncthreads();
    const int fr = lane & 15, fq = lane >> 4;
    for (int unit = bid * 8 + wave; unit < 16384; unit += gridDim.x * 8) {
        const int j = unit & 3, h = (unit >> 2) & 7, r = (unit >> 5) & 127, b = unit >> 12;
        const int tq = b * SEQ + r * 64 + 16 * j;
        const int rs = min(max(r - 4, 0), 120), c0 = min(max(16 * j - 8, 0), 32);
        const int qcol = 16 * j + fr, cs = min(max(qcol - 8, 0), 48);
        bf16_t* qp = QNA + (size_t)(tq + fr) * 512 + h * 64;
        const bf16x8 qf0 = *(const bf16x8*)(qp + 8 * fq), qf1 = *(const bf16x8*)(qp + 32 + 8 * fq);
        f32x4 s[16]; float mx = -INFINITY;
#pragma unroll
        for (int a = 0; a < 16; ++a) { const int kr = a >> 1, kc0 = (a & 1) * 16;
            const bf16_t* kp = KNA + (size_t)(b * SEQ + (rs + kr) * 64 + c0 + kc0 + fr) * 512 + h * 64 + 8 * fq;
            const bf16x8 kf0 = *(const bf16x8*)kp, kf1 = *(const bf16x8*)(kp + 32);
            f32x4 acc = {0.f, 0.f, 0.f, 0.f}; acc = MFMA16(kf0, qf0, acc); acc = MFMA16(kf1, qf1, acc);
            const LAS float* bp = ldsf + h * 465 + (rs + kr - r + 7) * 31;
#pragma unroll
            for (int v = 0; v < 4; ++v) { const int kcol = c0 + kc0 + 4 * fq + v; const bool valid = (kcol >= cs) && (kcol < cs + 16);
                const int bi = min(max(kcol - qcol + 15, 0), 30);
                const float sv = valid ? acc[v] + bp[bi] : -INFINITY; s[a][v] = sv; mx = fmaxf(mx, sv); } }
        mx = fmaxf(mx, __shfl_xor(mx, 16)); mx = fmaxf(mx, __shfl_xor(mx, 32));
        float l = 0.f;
#pragma unroll
        for (int a = 0; a < 16; ++a)
#pragma unroll
            for (int v = 0; v < 4; ++v) { const float p = __expf(s[a][v] - mx); s[a][v] = p; l += p; }
        l += __shfl_xor(l, 16); l += __shfl_xor(l, 32);
        const float rl = 1.f / l;
        f32x4 o[4];
#pragma unroll
        for (int dt = 0; dt < 4; ++dt) o[dt] = (f32x4){0.f, 0.f, 0.f, 0.f};
#pragma unroll
        for (int ks = 0; ks < 8; ++ks) {
            const bf16x8 pf = mk8(cvt_pk_bf16(s[2 * ks][0], s[2 * ks][1]), cvt_pk_bf16(s[2 * ks][2], s[2 * ks][3]), cvt_pk_bf16(s[2 * ks + 1][0], s[2 * ks + 1][1]), cvt_pk_bf16(s[2 * ks + 1][2], s[2 * ks + 1][3]));
            const size_t tk = (size_t)b * SEQ + (rs + ks) * 64 + c0 + 4 * fq;
#pragma unroll
            for (int dt = 0; dt < 4; ++dt) { const bf16_t* vp = VT + (size_t)(h * 64 + 16 * dt + fr) * MTOK + tk;
                const u32x2 lo = *(const u32x2*)vp, hi = *(const u32x2*)(vp + 16);
                o[dt] = MFMA16(mk8(lo.x, lo.y, hi.x, hi.y), pf, o[dt]); } }
#pragma unroll
        for (int dt = 0; dt < 4; ++dt) { u32x2 w; w.x = cvt_pk_bf16(o[dt][0] * rl, o[dt][1] * rl); w.y = cvt_pk_bf16(o[dt][2] * rl, o[dt][3] * rl);
            *(u32x2*)(qp + 16 * dt + 4 * fq) = w; }
    }
    __syncthreads();
}

__device__ __forceinline__ void ret_kv_phase(const bf16_t* KT, const bf16_t* VT, bf16_t* ST, const float* dec_f, const float* dec_b, int wave, int lane, int bid) {
    const int fr = lane & 15, fq = lane >> 4;
    for (int unit = bid; unit < 512; unit += gridDim.x) {
        const int c = unit & 31, bh = unit >> 5, h = bh & 3, b = bh >> 2;
        const size_t tok0 = (size_t)b * SEQ + c * 256;
        const float lgf = log2f(1.f / (1.f + expf(-dec_f[h]))), lgb = log2f(1.f / (1.f + expf(-dec_b[h])));
        f32x4 af[16], ab[16];
#pragma unroll
        for (int dt = 0; dt < 16; ++dt) { af[dt] = (f32x4){0.f, 0.f, 0.f, 0.f}; ab[dt] = (f32x4){0.f, 0.f, 0.f, 0.f}; }
        const bf16_t* kp = KT + (size_t)(h * 128 + 16 * wave + fr) * MTOK + tok0 + 8 * fq;
        const bf16_t* vp = VT + (size_t)(h * 256 + fr) * MTOK + tok0 + 8 * fq;
#pragma unroll 1
        for (int s = 0; s < 8; ++s) {
            const u32x4 kw = *(const u32x4*)(kp + 32 * s);
            const int j0 = 32 * s + 8 * fq;
            float zf[8], zb[8];
#pragma unroll
            for (int e = 0; e < 8; ++e) { zf[e] = exp2f(lgf * (float)(255 - j0 - e)); zb[e] = exp2f(lgb * (float)(j0 + e)); }
            const bf16x8 kf = mk8(cvt_pk_bf16(bflo(kw.x) * zf[0], bfhi(kw.x) * zf[1]), cvt_pk_bf16(bflo(kw.y) * zf[2], bfhi(kw.y) * zf[3]), cvt_pk_bf16(bflo(kw.z) * zf[4], bfhi(kw.z) * zf[5]), cvt_pk_bf16(bflo(kw.w) * zf[6], bfhi(kw.w) * zf[7]));
            const bf16x8 kb = mk8(cvt_pk_bf16(bflo(kw.x) * zb[0], bfhi(kw.x) * zb[1]), cvt_pk_bf16(bflo(kw.y) * zb[2], bfhi(kw.y) * zb[3]), cvt_pk_bf16(bflo(kw.z) * zb[4], bfhi(kw.z) * zb[5]), cvt_pk_bf16(bflo(kw.w) * zb[6], bfhi(kw.w) * zb[7]));
#pragma unroll
            for (int dt = 0; dt < 16; ++dt) { const bf16x8 vf = *(const bf16x8*)(vp + (size_t)(16 * dt) * MTOK + 32 * s);
                af[dt] = MFMA16(kf, vf, af[dt]); ab[dt] = MFMA16(kb, vf, ab[dt]); }
        }
        bf16_t* sf = ST + ((size_t)(bh * 32 + c) * 2) * 32768 + 16 * wave + 4 * fq;
#pragma unroll
        for (int dt = 0; dt < 16; ++dt) { u32x2 w; w.x = cvt_pk_bf16(af[dt][0], af[dt][1]); w.y = cvt_pk_bf16(af[dt][2], af[dt][3]); *(u32x2*)(sf + (size_t)(16 * dt + fr) * 128) = w;
            u32x2 x; x.x = cvt_pk_bf16(ab[dt][0], ab[dt][1]); x.y = cvt_pk_bf16(ab[dt][2], ab[dt][3]); *(u32x2*)(sf + 32768 + (size_t)(16 * dt + fr) * 128) = x; }
    }
}
__device__ __forceinline__ void ret_scan_phase(bf16_t* ST, const float* dec_f, const float* dec_b, int tid, int bid) {
    for (int g = bid * 512 + tid; g < 131072; g += gridDim.x * 512) {
        const int e8 = g & 4095, bhd = g >> 12, dir = bhd & 1, bh = bhd >> 1, h = bh & 3;
        const float lg = log2f(1.f / (1.f + expf(-(dir ? dec_b[h] : dec_f[h])))); const float dec = exp2f(256.f * lg);
        bf16_t* base = ST + ((size_t)(bh * 32) * 2 + dir) * 32768 + (size_t)e8 * 8;
        u32x4 v[32];
#pragma unroll
        for (int it = 0; it < 32; ++it) { const int c = dir ? 31 - it : it; v[it] = *(const u32x4*)(base + (size_t)c * 65536); }
        float S[8];
#pragma unroll
        for (int e = 0; e < 8; ++e) S[e] = 0.f;
#pragma unroll
        for (int it = 0; it < 32; ++it) { const int c = dir ? 31 - it : it;
            u32x4 w; w.x = cvt_pk_bf16(S[0], S[1]); w.y = cvt_pk_bf16(S[2], S[3]); w.z = cvt_pk_bf16(S[4], S[5]); w.w = cvt_pk_bf16(S[6], S[7]);
            *(u32x4*)(base + (size_t)c * 65536) = w;
            S[0] = S[0] * dec + bflo(v[it].x); S[1] = S[1] * dec + bfhi(v[it].x); S[2] = S[2] * dec + bflo(v[it].y); S[3] = S[3] * dec + bfhi(v[it].y);
            S[4] = S[4] * dec + bflo(v[it].z); S[5] = S[5] * dec + bfhi(v[it].z); S[6] = S[6] * dec + bflo(v[it].w); S[7] = S[7] * dec + bfhi(v[it].w); }
    }
}
__device__ __forceinline__ void ret_out_phase(const bf16_t* QR, const bf16_t* KR, const bf16_t* VT, const bf16_t* ST, bf16_t* GR, const float* dec_f, const float* dec_b, LAS unsigned char* ldsb, int wave, int lane, int bid) {
    const int fr = lane & 15, fq = lane >> 4;
    for (int unit = bid; unit < 512; unit += gridDim.x) {
        const int c = unit & 31, bh = unit >> 5, h = bh & 3, b = bh >> 2;
        const size_t tok0 = (size_t)b * SEQ + c * 256;
        const float lgf = log2f(1.f / (1.f + expf(-dec_f[h]))), lgb = log2f(1.f / (1.f + expf(-dec_b[h])));
        LAS bf16x8* qL = (LAS bf16x8*)(ldsb + wave * 8192) + lane;
#pragma unroll
        for (int mi = 0; mi < 2; ++mi)
#pragma unroll
            for (int ks = 0; ks < 4; ++ks) qL[(mi * 4 + ks) * 64] = *(const bf16x8*)(QR + (tok0 + 32 * wave + 16 * mi + fr) * 512 + h * 128 + 32 * ks + 8 * fq);
#define QF(mi, ks) (qL[((mi) * 4 + (ks)) * 64])
        f32x4 acc[16][2];
#pragma unroll
        for (int dt = 0; dt < 16; ++dt) { acc[dt][0] = (f32x4){0.f, 0.f, 0.f, 0.f}; acc[dt][1] = (f32x4){0.f, 0.f, 0.f, 0.f}; }
        const bf16_t* vbase = VT + (size_t)(h * 256 + fr) * MTOK + tok0 + 4 * fq;
#pragma unroll 1
        for (int s = 0; s < 8; ++s) {
            asm volatile("" ::: "memory");
            f32x4 st[2][2];
#pragma unroll
            for (int a01 = 0; a01 < 2; ++a01) { st[a01][0] = (f32x4){0.f, 0.f, 0.f, 0.f}; st[a01][1] = (f32x4){0.f, 0.f, 0.f, 0.f};
                const bf16_t* kp = KR + (tok0 + 32 * s + 16 * a01 + fr) * 512 + h * 128 + 8 * fq;
#pragma unroll
                for (int ks = 0; ks < 4; ++ks) { const bf16x8 kf = *(const bf16x8*)(kp + 32 * ks);
                    st[a01][0] = MFMA16(kf, QF(0, ks), st[a01][0]); st[a01][1] = MFMA16(kf, QF(1, ks), st[a01][1]); }
#pragma unroll
                for (int mi = 0; mi < 2; ++mi)
#pragma unroll
                    for (int v = 0; v < 4; ++v) { const int d = (32 * wave + 16 * mi + fr) - (32 * s + 16 * a01 + 4 * fq + v);
                        st[a01][mi][v] *= exp2f(d >= 0 ? lgf * (float)d : lgb * (float)(-d)); } }
            const bf16x8 pf0 = mk8(cvt_pk_bf16(st[0][0][0], st[0][0][1]), cvt_pk_bf16(st[0][0][2], st[0][0][3]), cvt_pk_bf16(st[1][0][0], st[1][0][1]), cvt_pk_bf16(st[1][0][2], st[1][0][3]));
            const bf16x8 pf1 = mk8(cvt_pk_bf16(st[0][1][0], st[0][1][1]), cvt_pk_bf16(st[0][1][2], st[0][1][3]), cvt_pk_bf16(st[1][1][0], st[1][1][1]), cvt_pk_bf16(st[1][1][2], st[1][1][3]));
#pragma unroll
            for (int dt = 0; dt < 16; ++dt) { const bf16_t* vp = vbase + (size_t)(16 * dt) * MTOK + 32 * s;
                const u32x2 lo = *(const u32x2*)vp, hi = *(const u32x2*)(vp + 16); const bf16x8 vf = mk8(lo.x, lo.y, hi.x, hi.y);
                acc[dt][0] = MFMA16(vf, pf0, acc[dt][0]); acc[dt][1] = MFMA16(vf, pf1, acc[dt][1]); if ((dt & 3) == 3) __builtin_amdgcn_sched_barrier(0); }
        }
#pragma unroll 1
        for (int dir = 0; dir < 2; ++dir) {
            const bf16_t* sp = ST + ((size_t)(bh * 32 + c) * 2 + dir) * 32768 + (size_t)fr * 128 + 8 * fq;
            const int i0 = 32 * wave + fr;
            const float sc0 = dir ? exp2f(lgb * (float)(256 - i0)) : exp2f(lgf * (float)(i0 + 1));
            const float sc1 = dir ? exp2f(lgb * (float)(256 - i0 - 16)) : exp2f(lgf * (float)(i0 + 17));
#pragma unroll
            for (int ks = 0; ks < 4; ++ks) { asm volatile("" ::: "memory"); const bf16x8 qs0 = scale8(QF(0, ks), sc0), qs1 = scale8(QF(1, ks), sc1);
#pragma unroll
                for (int dt = 0; dt < 16; ++dt) { const bf16x8 sf = *(const bf16x8*)(sp + (size_t)(16 * dt) * 128 + 32 * ks);
                    acc[dt][0] = MFMA16(sf, qs0, acc[dt][0]); acc[dt][1] = MFMA16(sf, qs1, acc[dt][1]); if ((dt & 3) == 3) __builtin_amdgcn_sched_barrier(0); } }
        }
#pragma unroll
        for (int mi = 0; mi < 2; ++mi) {
            float sm = 0.f;
#pragma unroll
            for (int dt = 0; dt < 16; ++dt) sm += (acc[dt][mi][0] + acc[dt][mi][1]) + (acc[dt][mi][2] + acc[dt][mi][3]);
            sm += __shfl_xor(sm, 16); sm += __shfl_xor(sm, 32);
            const float mu = sm * (1.f / 256.f); float sq = 0.f;
#pragma unroll
            for (int dt = 0; dt < 16; ++dt) { const f32x4 d = acc[dt][mi] - mu; sq += (d[0] * d[0] + d[1] * d[1]) + (d[2] * d[2] + d[3] * d[3]); }
            sq += __shfl_xor(sq, 16); sq += __shfl_xor(sq, 32);
            const float rstd = 1.f / sqrtf(sq * (1.f / 256.f) + GN_EPS);
            bf16_t* gp = GR + (tok0 + 32 * wave + 16 * mi + fr) * 1024 + h * 256 + 4 * fq;
#pragma unroll
            for (int dt = 0; dt < 16; ++dt) { const u32x2 gw = *(const u32x2*)(gp + 16 * dt);
                const float g0 = bflo(gw.x), g1 = bfhi(gw.x), g2 = bflo(gw.y), g3 = bfhi(gw.y); const f32x4 o = (acc[dt][mi] - mu) * rstd;
                u32x2 w; w.x = cvt_pk_bf16(g0 * sigm(g0) * o[0], g1 * sigm(g1) * o[1]); w.y = cvt_pk_bf16(g2 * sigm(g2) * o[2], g3 * sigm(g3) * o[3]);
                *(u32x2*)(gp + 16 * dt) = w; }
        }
    }
}
#undef QF
__device__ __forceinline__ void conv_glu_phase(const bf16_t* H, bf16_t* U, int NP, int aoff, const float* cw, const float* cb, int tid, int bid) {
    const int ncg = NP / 8, nitems = (MTOK / 32) * ncg;
    for (int item = bid * 512 + tid; item < nitems; item += gridDim.x * 512) {
        const int cgp = item % ncg, strip = item / ncg, j0 = cgp * 8, t0 = strip * 32;
        float wa[3][8], wb[3][8], ba[8], bb[8];
#pragma unroll
        for (int e = 0; e < 8; ++e) {
#pragma unroll
            for (int k = 0; k < 3; ++k) { wa[k][e] = cw[k * 5632 + aoff + j0 + e]; wb[k][e] = cw[k * 5632 + 2816 + aoff + j0 + e]; }
            ba[e] = cb[aoff + j0 + e]; bb[e] = cb[2816 + aoff + j0 + e]; }
        const bf16_t* hp = H + (size_t)t0 * (2 * NP) + j0;
        u32x4 pa, pb, ca, cb_, na, nb;
        const u32x4 z4 = {0u, 0u, 0u, 0u};
        if ((t0 & (SEQ - 1)) != 0) { pa = *(const u32x4*)(hp - (size_t)(2 * NP)); pb = *(const u32x4*)(hp - (size_t)(2 * NP) + NP); } else { pa = z4; pb = z4; }
        ca = *(const u32x4*)hp; cb_ = *(const u32x4*)(hp + NP);
#pragma unroll 1
        for (int r = 0; r < 32; ++r) {
            const int t = t0 + r;
            if ((t & (SEQ - 1)) != SEQ - 1) { na = *(const u32x4*)(hp + (size_t)(r + 1) * (2 * NP)); nb = *(const u32x4*)(hp + (size_t)(r + 1) * (2 * NP) + NP); } else { na = z4; nb = z4; }
            float o[8];
#define CG_ONE(e, PW, CW, NW, PWB, CWB, NWB, LOHI) { const float a = wa[0][e] * LOHI(PW) + wa[1][e] * LOHI(CW) + wa[2][e] * LOHI(NW) + ba[e]; \
                const float bq = wb[0][e] * LOHI(PWB) + wb[1][e] * LOHI(CWB) + wb[2][e] * LOHI(NWB) + bb[e]; o[e] = gelu_tanh(a) * bq; }
            CG_ONE(0, pa.x, ca.x, na.x, pb.x, cb_.x, nb.x, bflo) CG_ONE(1, pa.x, ca.x, na.x, pb.x, cb_.x, nb.x, bfhi)
            CG_ONE(2, pa.y, ca.y, na.y, pb.y, cb_.y, nb.y, bflo) CG_ONE(3, pa.y, ca.y, na.y, pb.y, cb_.y, nb.y, bfhi)
            CG_ONE(4, pa.z, ca.z, na.z, pb.z, cb_.z, nb.z, bflo) CG_ONE(5, pa.z, ca.z, na.z, pb.z, cb_.z, nb.z, bfhi)
            CG_ONE(6, pa.w, ca.w, na.w, pb.w, cb_.w, nb.w, bflo) CG_ONE(7, pa.w, ca.w, na.w, pb.w, cb_.w, nb.w, bfhi)
#undef CG_ONE
            u32x4 w; w.x = cvt_pk_bf16(o[0], o[1]); w.y = cvt_pk_bf16(o[2], o[3]); w.z = cvt_pk_bf16(o[4], o[5]); w.w = cvt_pk_bf16(o[6], o[7]);
            *(u32x4*)(U + (size_t)t * NP + j0) = w;
            pa = ca; pb = cb_; ca = na; cb_ = nb;
        }
    }
}

#ifndef PH_MASK
#define PH_MASK 0xFFFFFFFFu
#endif
#define PH(n) ((PH_MASK >> (n)) & 1u)
struct Args { const float* in[19]; float* out; unsigned char* ws; };
constexpr int LDS_BYTES = 147456;
__device__ __forceinline__ int otid() { int t = threadIdx.x; asm volatile("" : "+v"(t)); return t; }
__device__ __forceinline__ int obid() { int b = blockIdx.x; asm volatile("" : "+s"(b)); return b; }
typedef const unsigned long long __attribute__((address_space(4)))* kptr_t;
__device__ __forceinline__ kptr_t kargs_() { kptr_t p = (kptr_t)__builtin_amdgcn_kernarg_segment_ptr(); asm volatile("" : "+s"(p)); return p; }
#define KIN(k) ((const float*)kargs_()[k])
#define KOUT ((float*)kargs_()[19])
#define KWS ((unsigned char*)kargs_()[20])
#define LOADIN(in) In in; { kptr_t kp_ = kargs_(); _Pragma("unroll") for (int i_ = 0; i_ < 19; ++i_) in.p[i_] = (const float*)kp_[i_]; }
#define TSET const int tid = otid(), lane = tid & 63, wave = __builtin_amdgcn_readfirstlane(tid >> 6), bid = obid(), gw = bid * 8 + wave, NGW = (int)gridDim.x * 8; (void)lane; (void)gw; (void)NGW; (void)tid;
#define GEMM(EpiT, Aptr, Bptr, Mv, Nv, Kv, Eobj) do { Gemm g_{(const bf16_t*)(Aptr), (const bf16_t*)(Bptr), (Mv), (Nv), (Kv)}; StaticOrder S_; S_.init((Mv), (Nv), (int)gridDim.x, obid()); \
        gemm_phase<EpiT, StaticOrder, true, true>(ldsp, g_, S_, (Eobj)); } while (0)
#define PHASE_FENCE() do { __builtin_amdgcn_fence(__ATOMIC_RELEASE, "agent"); __builtin_amdgcn_fence(__ATOMIC_ACQUIRE, "agent"); __syncthreads(); } while (0)

#define P_(off) ((bf16_t*)(KWS + (off)))
#define cosT ((float*)(KWS + WS_COS))
#define sinT ((float*)(KWS + WS_SIN))
#define Wb P_(WS_W)
#define xout KOUT
template <int layer> __device__ __forceinline__ void layer_body(unsigned char* lds, PG8_LAS unsigned char* ldsp, cg::grid_group& grid) {
        if (PH(1)) { EpiProj E{P_(WS_QNA), P_(WS_KNA), P_(WS_QR), P_(WS_KR), P_(WS_KT), P_(WS_GR), cosT, sinT}; GEMM(EpiProj, P_(WS_XB), Wb + W_IN, MTOK, 3072, 1024, E); }
        __syncthreads();
        if (PH(2)) { EpiVT E{P_(WS_VTNA), P_(WS_VTR)}; GEMM(EpiVT, Wb + W_IN + (size_t)3072 * 1024, P_(WS_XB), 1536, MTOK, 1024, E); }
        grid.sync();
        if (PH(3)) { TSET ret_kv_phase(P_(WS_KT), P_(WS_VTR), P_(WS_ST), KIN(4) + layer * 4, KIN(5) + layer * 4, wave, lane, bid); }
        __syncthreads();
        if (PH(4)) { TSET na_phase(P_(WS_QNA), P_(WS_KNA), P_(WS_VTNA), KIN(3) + layer * 3720, (LAS float*)lds, tid, wave, lane, bid); }
        grid.sync();
        if (PH(5)) { TSET ret_scan_phase(P_(WS_ST), KIN(4) + layer * 4, KIN(5) + layer * 4, tid, bid); }
        grid.sync();
        if (PH(6)) { TSET ret_out_phase(P_(WS_QR), P_(WS_KR), P_(WS_VTR), P_(WS_ST), P_(WS_GR), KIN(4) + layer * 4, KIN(5) + layer * 4, (LAS unsigned char*)lds, wave, lane, bid); }
        __syncthreads();
        if (PH(7)) { EpiBf<2> E{P_(WS_GA), P_(WS_GB), 4, 1024}; GEMM(EpiBf<2>, P_(WS_XB), Wb + W_IN + (size_t)4608 * 1024, MTOK, 2048, 1024, E); }
        grid.sync();
        if (PH(8)) { EpiMerge<0> E{P_(WS_MRG), P_(WS_GA)}; GEMM(EpiMerge<0>, P_(WS_QNA), Wb + W_A, MTOK, 1024, 512, E); }
        PHASE_FENCE();
        if (PH(9)) { EpiMerge<1> E{P_(WS_MRG), P_(WS_GB)}; GEMM(EpiMerge<1>, P_(WS_GR), Wb + W_B, MTOK, 1024, 1024, E); }
        grid.sync();
        if (PH(10)) { EpiF32<0> E{xout, layer == 0 ? KIN(0) : xout, nullptr}; GEMM(EpiF32<0>, P_(WS_MRG), Wb + W_O, MTOK, 1024, 1024, E); }
        grid.sync();
        if (PH(11)) { TSET for (int m = gw; m < MTOK; m += NGW) ln_row(xout + (size_t)m * DM, xout + (size_t)m * DM, P_(WS_XB) + (size_t)m * DM, KIN(9) + layer * DM, KIN(10) + layer * DM, lane); }
        grid.sync();
        if (PH(12)) { EpiBf<0> E{P_(WS_H), P_(WS_H), 1 << 20, 2 * FF1}; GEMM(EpiBf<0>, P_(WS_XB), Wb + W_UP, MTOK, 2 * FF1, 1024, E); }
        __syncthreads();
        if (PH(13)) { EpiBf<2> E{P_(WS_SG), P_(WS_SG), 1 << 20, 1024}; GEMM(EpiBf<2>, P_(WS_XB), Wb + W_PG, MTOK, 1024, 1024, E); }
        PHASE_FENCE();
        if (PH(14)) { EpiF32<1> E{xout, nullptr, P_(WS_SG)}; GEMM(EpiF32<1>, P_(WS_PB), Wb + W_PP, MTOK, 1024, 256, E); }
        grid.sync();
        if (PH(15)) { TSET conv_glu_phase(P_(WS_H), P_(WS_U), FF1, 0, KIN(12) + (size_t)layer * 3 * 5632, KIN(13) + (size_t)layer * 5632, tid, bid); }
        grid.sync();
        if (PH(16)) { EpiF32<2> E{xout, nullptr, nullptr}; GEMM(EpiF32<2>, P_(WS_U), Wb + W_D1, MTOK, 1024, FF1, E); }
        __syncthreads();
        if (PH(17)) { EpiBf<0> E{P_(WS_H), P_(WS_H), 1 << 20, 2 * FF2}; GEMM(EpiBf<0>, P_(WS_XB), Wb + W_UP + (size_t)(2 * FF1) * 1024, MTOK, 2 * FF2, 1024, E); }
        grid.sync();
        if (PH(18)) { TSET conv_glu_phase(P_(WS_H), P_(WS_U), FF2, FF1, KIN(12) + (size_t)layer * 3 * 5632, KIN(13) + (size_t)layer * 5632, tid, bid); }
        grid.sync();
        if (PH(19)) { EpiF32<2> E{xout, nullptr, nullptr}; GEMM(EpiF32<2>, P_(WS_U), Wb + W_D2, MTOK, 1024, FF2, E); }
        grid.sync();
        if (PH(11)) { TSET for (int m = gw; m < MTOK; m += NGW) ln_row(xout + (size_t)m * DM, xout + (size_t)m * DM, P_(WS_XB) + (size_t)m * DM, KIN(17) + layer * DM, KIN(18) + layer * DM, lane); }
        if (layer + 1 < NLAYER) { TSET if (PH(0)) { LOADIN(in) convert_layer(in, layer + 1, Wb, P_(WS_PB), (LAS float*)(lds + wave * 16384), gw, NGW, lane); } grid.sync(); }
}

__global__ void __launch_bounds__(512, 2) mk_fwd(Args args) {
    extern __shared__ __attribute__((aligned(16))) unsigned char lds[];
    cg::grid_group grid = cg::this_grid();
    PG8_LAS unsigned char* ldsp = (PG8_LAS unsigned char*)lds;
    { TSET
      if (PH(0)) { LOADIN(in) convert_layer(in, 0, Wb, P_(WS_PB), (LAS float*)(lds + wave * 16384), gw, NGW, lane); }
      float* cT = cosT; float* sT = sinT;
      for (int i = bid * 512 + tid; i < SEQ * 64; i += (int)gridDim.x * 512) { const int t = i >> 6, j = i & 63;
          const float inv = powf(10000.f, -(float)j * (1.f / 64.f)); const float ang = (float)t * inv; cT[i] = cosf(ang); sT[i] = sinf(ang); }
      const float* x = KIN(0); bf16_t* XB = P_(WS_XB);
      for (size_t i = (size_t)(bid * 512 + tid) * 8; i < (size_t)MTOK * DM; i += (size_t)gridDim.x * 512 * 8) { const f32x4 a = *(const f32x4*)(x + i), b = *(const f32x4*)(x + i + 4);
          u32x4 w; w.x = cvt_pk_bf16(a[0], a[1]); w.y = cvt_pk_bf16(a[2], a[3]); w.z = cvt_pk_bf16(b[0], b[1]); w.w = cvt_pk_bf16(b[2], b[3]); *(u32x4*)(XB + i) = w; } }
    grid.sync();

    layer_body<0>(lds, ldsp, grid);
    layer_body<1>(lds, ldsp, grid);
    layer_body<2>(lds, ldsp, grid);
    layer_body<3>(lds, ldsp, grid);
}

extern "C" void kernel_launch(void* const* d_in, const int* in_sizes, int n_in, void* d_out, int out_size, void* d_ws, size_t ws_size, hipStream_t stream) {
    static int grid = 0;
    if (grid == 0) {
        if (n_in != 19 || out_size != MTOK * DM || ws_size < WS_END) { fprintf(stderr, "kernel_launch: unexpected shapes (n_in %d out %d ws %zu)\n", n_in, out_size, ws_size); grid = -1; return; }
        int dev = 0, cus = 0;
        if (hipGetDevice(&dev) != hipSuccess || hipDeviceGetAttribute(&cus, hipDeviceAttributeMultiprocessorCount, dev) != hipSuccess) { grid = -1; return; }
        if (hipFuncSetAttribute((const void*)mk_fwd, hipFuncAttributeMaxDynamicSharedMemorySize, LDS_BYTES) != hipSuccess) { fprintf(stderr, "kernel_launch: hipFuncSetAttribute failed\n"); grid = -1; return; }
        int per_cu = 0;
        if (hipOccupancyMaxActiveBlocksPerMultiprocessor(&per_cu, (const void*)mk_fwd, 512, LDS_BYTES) != hipSuccess || per_cu < 1) fprintf(stderr, "kernel_launch: occupancy query says %d\n", per_cu);
        (void)hipGetLastError();
        grid = cus;
    }
    if (grid < 0) return;
    Args a{};
    for (int i = 0; i < 19; ++i) a.in[i] = (const float*)d_in[i];
    a.out = (float*)d_out; a.ws = (unsigned char*)d_ws;
    void* kargs[] = {&a};
    hipError_t e = hipLaunchCooperativeKernel((const void*)mk_fwd, dim3(grid), dim3(512), kargs, LDS_BYTES, stream);
    if (e != hipSuccess) fprintf(stderr, "kernel_launch: cooperative launch failed: %s (grid %d)\n", hipGetErrorString(e), grid);
}
```

```cpp
#include <hip/hip_runtime.h>
#include <hip/hip_cooperative_groups.h>
#include <cstdio>
#include <cstdint>
namespace cg = cooperative_groups;
namespace pg8 {
#define PG8_LAS __attribute__((address_space(3)))
typedef unsigned short bf16_t;
typedef short bf16x8 __attribute__((ext_vector_type(8)));
typedef float f32x4 __attribute__((ext_vector_type(4)));
typedef unsigned u32x4 __attribute__((ext_vector_type(4)));
constexpr int BM = 256, BK = 64, HALF = 128, HTB = HALF * BK * 2  , STAGE_BYTES = 8 * HTB, NXCD = 8, WGM = 8;

__host__ __device__ __forceinline__ int lds_byte(int r, int c) { const int st = (r >> 4) * 2 + (c >> 5), rr = r & 15, cc = c & 31, ob = rr * 64 + cc * 2; return st * 1024 + (ob ^ (((ob >> 9) & 1) << 5)); }
__host__ __device__ __forceinline__ void stage_rc(int b, int& R, int& C) { const int st = b / 1024, sb = b % 1024, swz = sb ^ (((sb >> 9) & 1) << 5); R = (st >> 1) * 16 + swz / 64; C = (st & 1) * 32 + (swz % 64) / 2; }
__host__ __device__ __forceinline__ int perm32(int rho) { const int n = rho >> 4, i = rho & 15; return 8 * (i >> 2) + 4 * n + (i & 3); }

struct Unit { int pm, pn; };
struct Gemm { const bf16_t* A; const bf16_t* Bt; int M, N, K; };

struct StaticOrder {
    int nM, nN, nwg, G, c;
    __host__ __device__ void init(int M, int N, int G_, int c_) { nM = M / BM; nN = N / BM; nwg = nM * nN; G = G_; c = c_; }
    __host__ __device__ bool next(int i, Unit& u) const {
        const long L = (long)i * G + c; if (L >= nwg) return false;
        int wgid = (int)L; { const int q = nwg / NXCD, r = nwg % NXCD, xcd = wgid % NXCD, off = wgid / NXCD; wgid = (xcd < r ? xcd * (q + 1) : r * (q + 1) + (xcd - r) * q) + off; }
        const int nig = WGM * nN, gid = wgid / nig, fm = gid * WGM, gsz = (nM - fm) < WGM ? (nM - fm) : WGM;
        u.pm = fm + ((wgid % nig) % gsz); u.pn = (wgid % nig) / gsz; return true;
    }
    __device__ __forceinline__ void a_ready(const Unit&) const {}
    __device__ __forceinline__ void done(const Unit&) const {}
};

__device__ __forceinline__ unsigned cvt_pk_bf16(float lo, float hi) { unsigned r; asm volatile("v_cvt_pk_bf16_f32 %0, %1, %2" : "=v"(r) : "v"(lo), "v"(hi)); return r; }
template <class Epi, class Sched, bool ALIGN_EPI = false, bool SP2 = false>
__device__ __forceinline__ void gemm_phase(PG8_LAS unsigned char* lds, const Gemm g, const Sched& S, const Epi& E) {
    int tid_raw_ = threadIdx.x; asm volatile("" : "+v"(tid_raw_)); const int tid = tid_raw_, wid = __builtin_amdgcn_readfirstlane(tid >> 6), lane = tid & 63, wr = wid >> 2, wc = wid & 3, fr = lane & 15, fq = lane >> 4;
    const int K = g.K, nt = K / BK;
    unsigned voffA[2], voffB[2];
#pragma unroll
    for (int i = 0; i < 2; ++i) { int R, C; stage_rc(tid * 16 + i * 8192, R, C); const int Rb = Epi::PERM ? ((R & ~31) + perm32(R & 31)) : R;
        voffA[i] = (unsigned)(R * K + C) * 2u; voffB[i] = (unsigned)(Rb * K + C) * 2u; }
    const size_t kstep = (size_t)(BK * 2);
    const size_t hstep = (size_t)HALF * K * 2;
    const size_t tstep = 2 * hstep;
    const unsigned ldsw = (unsigned)wid * 1024u;
    const int aoff = lds_byte(wr * 64 + fr, fq * 8), boff = lds_byte(wc * 32 + fr, fq * 8);
#define PG8_SA(b, h) (((b) * 2 + (h)) * HTB)
#define PG8_SB(b, h) ((4 + (b) * 2 + (h)) * HTB)
#define PG8_STAGE(bufoff, gbase, voff) do { _Pragma("unroll") for (int _i = 0; _i < 2; ++_i) \
        __builtin_amdgcn_global_load_lds((const unsigned*)((const char*)(gbase) + (voff)[_i]), (PG8_LAS unsigned*)(lds + (bufoff) + ldsw + _i * 8192), 16, 0, 0); } while (0)
#define PG8_LDA(dst, b, h) do { _Pragma("unroll") for (int m = 0; m < 4; ++m) _Pragma("unroll") for (int k = 0; k < 2; ++k) dst[m][k] = *(const PG8_LAS bf16x8*)(lds + PG8_SA(b, h) + aoff + m * 2048 + k * 1024); } while (0)
#define PG8_LDB(dst, b, h) do { _Pragma("unroll") for (int n = 0; n < 2; ++n) _Pragma("unroll") for (int k = 0; k < 2; ++k) dst[n][k] = *(const PG8_LAS bf16x8*)(lds + PG8_SB(b, h) + boff + n * 2048 + k * 1024); } while (0)
#define PG8_MMA(ai, bj, At, Bt) do { __builtin_amdgcn_s_setprio(1); _Pragma("unroll") for (int m = 0; m < 4; ++m) _Pragma("unroll") for (int n = 0; n < 2; ++n) _Pragma("unroll") for (int k = 0; k < 2; ++k) \
        acc[ai][bj][m][n] = __builtin_amdgcn_mfma_f32_16x16x32_bf16(Bt[n][k], At[m][k], acc[ai][bj][m][n], 0, 0, 0); __builtin_amdgcn_s_setprio(0); } while (0)
#define PG8_WAIT_V(n) asm volatile("s_waitcnt vmcnt(" #n ")" ::: "memory")
#define PG8_WAIT_L(n) asm volatile("s_waitcnt lgkmcnt(" #n ")" ::: "memory")
#define PG8_BAR __builtin_amdgcn_s_barrier()
#define PG8_SCHED __builtin_amdgcn_sched_barrier(0)
    Unit cur, nxt; int ui = 0;
    if (!S.next(0, cur)) return;
    f32x4 acc[2][2][4][2];
#pragma unroll
    for (int a = 0; a < 2; ++a)
#pragma unroll
        for (int b = 0; b < 2; ++b)
#pragma unroll
            for (int m = 0; m < 4; ++m)
#pragma unroll
                for (int n = 0; n < 2; ++n) acc[a][b][m][n] = (f32x4){0.f, 0.f, 0.f, 0.f};
    bf16x8 At[4][2], B0[2][2], B1[2][2];
    const char* cA = (const char*)g.A + (size_t)cur.pm * tstep; const char* cB = (const char*)g.Bt + (size_t)cur.pn * tstep;
    S.a_ready(cur);
    if constexpr (SP2) {
        PG8_STAGE(PG8_SB(0, 0), cB, voffB); PG8_STAGE(PG8_SB(0, 1), cB + hstep, voffB); PG8_STAGE(PG8_SA(0, 0), cA, voffA); PG8_STAGE(PG8_SA(0, 1), cA + hstep, voffA);
        if (wr == 1) PG8_BAR;
        PG8_WAIT_V(2); PG8_BAR;
        PG8_STAGE(PG8_SB(1, 0), cB + kstep, voffB); PG8_STAGE(PG8_SA(1, 0), cA + kstep, voffA); PG8_STAGE(PG8_SB(1, 1), cB + hstep + kstep, voffB);
        PG8_WAIT_V(6); PG8_BAR;
    } else {
        PG8_STAGE(PG8_SB(0, 0), cB, voffB); PG8_STAGE(PG8_SA(0, 0), cA, voffA); PG8_STAGE(PG8_SB(0, 1), cB + hstep, voffB); PG8_STAGE(PG8_SA(0, 1), cA + hstep, voffA);
        if (wr == 1) PG8_BAR;
        PG8_WAIT_V(4); PG8_BAR;
        PG8_STAGE(PG8_SB(1, 0), cB + kstep, voffB); PG8_STAGE(PG8_SA(1, 0), cA + kstep, voffA); PG8_STAGE(PG8_SB(1, 1), cB + hstep + kstep, voffB);
        PG8_WAIT_V(6); PG8_BAR;
    }
    for (;;) {
        const bool has_next = S.next(ui + 1, nxt);
        const char* nA = has_next ? (const char*)g.A + (size_t)nxt.pm * tstep : cA; const char* nB = has_next ? (const char*)g.Bt + (size_t)nxt.pn * tstep : cB;
        for (int t = 0; t < nt; t += 2) {
            const bool last = (t == nt - 2);
            const char* a1 = cA + (size_t)(t + 1) * kstep;
            const char* a2 = last ? nA : cA + (size_t)(t + 2) * kstep; const char* b2 = last ? nB : cB + (size_t)(t + 2) * kstep;
            const char* a3 = a2 + kstep; const char* b3 = b2 + kstep;
            if (last && has_next) S.a_ready(nxt);
            if constexpr (SP2) {
            PG8_LDB(B0, 0, 0); PG8_LDB(B1, 0, 1); PG8_SCHED; PG8_LDA(At, 0, 0); PG8_STAGE(PG8_SA(1, 1), a1 + hstep, voffA);
            PG8_WAIT_V(8); PG8_WAIT_L(0); PG8_BAR; PG8_MMA(0, 0, At, B0); PG8_MMA(0, 1, At, B1); PG8_BAR; PG8_SCHED;
            PG8_LDA(At, 0, 1); PG8_STAGE(PG8_SB(0, 0), b2, voffB); PG8_STAGE(PG8_SB(0, 1), b2 + hstep, voffB); PG8_STAGE(PG8_SA(0, 0), a2, voffA);
            PG8_WAIT_V(8); PG8_WAIT_L(0); PG8_BAR; PG8_MMA(1, 0, At, B0); PG8_MMA(1, 1, At, B1); PG8_BAR; PG8_SCHED;
            PG8_LDB(B0, 1, 0); PG8_LDB(B1, 1, 1); PG8_SCHED; PG8_LDA(At, 1, 0); PG8_STAGE(PG8_SA(0, 1), a2 + hstep, voffA);
            PG8_WAIT_V(8); PG8_WAIT_L(0); PG8_BAR; PG8_MMA(0, 0, At, B0); PG8_MMA(0, 1, At, B1); PG8_BAR; PG8_SCHED;
            PG8_LDA(At, 1, 1); PG8_STAGE(PG8_SB(1, 0), b3, voffB); PG8_STAGE(PG8_SB(1, 1), b3 + hstep, voffB); PG8_STAGE(PG8_SA(1, 0), a3, voffA);
            PG8_WAIT_V(8); PG8_WAIT_L(0); PG8_BAR; PG8_MMA(1, 0, At, B0); PG8_MMA(1, 1, At, B1); PG8_BAR; PG8_SCHED;
            } else {
            PG8_LDB(B0, 0, 0); PG8_SCHED; PG8_LDA(At, 0, 0); PG8_STAGE(PG8_SA(1, 1), a1 + hstep, voffA);
            PG8_WAIT_L(8); PG8_BAR; PG8_WAIT_L(0); PG8_MMA(0, 0, At, B0); PG8_BAR; PG8_SCHED;
            PG8_LDB(B1, 0, 1); PG8_STAGE(PG8_SB(0, 0), b2, voffB);
            PG8_BAR; PG8_WAIT_L(0); PG8_MMA(0, 1, At, B1); PG8_BAR;
            PG8_LDA(At, 0, 1); PG8_STAGE(PG8_SA(0, 0), a2, voffA);
            PG8_BAR; PG8_WAIT_L(0); PG8_MMA(1, 0, At, B0); PG8_BAR; PG8_SCHED;
            PG8_STAGE(PG8_SB(0, 1), b2 + hstep, voffB);
            PG8_WAIT_V(6); PG8_BAR; PG8_MMA(1, 1, At, B1); PG8_BAR;
            PG8_LDB(B0, 1, 0); PG8_SCHED; PG8_LDA(At, 1, 0); PG8_STAGE(PG8_SA(0, 1), a2 + hstep, voffA);
            PG8_WAIT_L(8); PG8_BAR; PG8_WAIT_L(0); PG8_MMA(0, 0, At, B0); PG8_BAR; PG8_SCHED;
            PG8_LDB(B1, 1, 1); PG8_STAGE(PG8_SB(1, 0), b3, voffB);
            PG8_BAR; PG8_WAIT_L(0); PG8_MMA(0, 1, At, B1); PG8_BAR;
            PG8_LDA(At, 1, 1); PG8_STAGE(PG8_SA(1, 0), a3, voffA);
            PG8_BAR; PG8_WAIT_L(0); PG8_MMA(1, 0, At, B0); PG8_BAR; PG8_SCHED;
            PG8_STAGE(PG8_SB(1, 1), b3 + hstep, voffB);
            PG8_WAIT_V(6); PG8_BAR; PG8_MMA(1, 1, At, B1); PG8_BAR;
            }
        }
        if constexpr (ALIGN_EPI) { if (wr == 0) PG8_BAR; }
        if constexpr (!Epi::AFTER_DRAIN) { E(acc, cur, wr, wc, fr, fq); S.done(cur); }
        if (!has_next) break;
#pragma unroll
        for (int a = 0; a < 2; ++a)
#pragma unroll
            for (int b = 0; b < 2; ++b)
#pragma unroll
                for (int m = 0; m < 4; ++m)
#pragma unroll
                    for (int n = 0; n < 2; ++n) acc[a][b][m][n] = (f32x4){0.f, 0.f, 0.f, 0.f};
        cur = nxt; cA = nA; cB = nB; ++ui;
        if constexpr (ALIGN_EPI) { if (wr == 1) PG8_BAR; }
    }
    PG8_WAIT_V(0);
    if constexpr (!ALIGN_EPI) { if (wr == 0) PG8_BAR; }
    PG8_BAR;
    if constexpr (Epi::AFTER_DRAIN) { E.fused(acc, cur, wr, wc, fr, fq, lds, wid, lane); S.done(cur); }
#undef PG8_SA
#undef PG8_SB
#undef PG8_STAGE
#undef PG8_LDA
#undef PG8_LDB
#undef PG8_MMA
#undef PG8_WAIT_V
#undef PG8_WAIT_L
#undef PG8_BAR
#undef PG8_SCHED
}
}

using namespace pg8;
#define LAS __attribute__((address_space(3)))
typedef unsigned u32x2 __attribute__((ext_vector_type(2)));
constexpr int MTOK = 32768, DM = 1024, SEQ = 8192, NLAYER = 4;
constexpr float ALPHA = 1.681792830507429f;
constexpr float LN_EPS = 1e-5f, GN_EPS = 1e-6f;
constexpr size_t MiB = 1u << 20;
constexpr size_t WS_COS = 1 * MiB, WS_SIN = 3 * MiB, WS_W = 6 * MiB, WS_XB = 44 * MiB, WS_QNA = 108 * MiB, WS_KNA = 140 * MiB, WS_VTNA = 172 * MiB,
                 WS_KT = 204 * MiB, WS_QR = 268 * MiB, WS_KR = 300 * MiB, WS_VTR = 332 * MiB, WS_GR = 396 * MiB, WS_ST = 460 * MiB, WS_PB = 524 * MiB,
                 WS_GA = 140 * MiB, WS_GB = 204 * MiB, WS_MRG = 268 * MiB, WS_SG = 108 * MiB, WS_H = 172 * MiB, WS_U = 364 * MiB, WS_END = 540 * MiB;
constexpr size_t W_IN = 0, W_A = W_IN + (size_t)6656 * 1024, W_B = W_A + (size_t)1024 * 512, W_O = W_B + (size_t)1024 * 1024, W_UP = W_O + (size_t)1024 * 1024,
                 W_D1 = W_UP + (size_t)5632 * 1024, W_D2 = W_D1 + (size_t)1024 * 1536, W_PG = W_D2 + (size_t)1024 * 1280, W_PP = W_PG + (size_t)1024 * 1024, W_TOTAL = W_PP + (size_t)1024 * 256;
static_assert(W_TOTAL * 2 <= 38 * MiB, "weights fit");
constexpr int FF1 = 1536, FF2 = 1280;

__device__ __forceinline__ float bflo(unsigned w) { return __uint_as_float(w << 16); }
__device__ __forceinline__ float bfhi(unsigned w) { return __uint_as_float(w & 0xffff0000u); }
__device__ __forceinline__ float sigm(float x) { return 1.f / (1.f + __expf(-x)); }
__device__ __forceinline__ float gelu_tanh(float x) { const float y = 0.7978845608028654f * (x + 0.044715f * x * x * x); const float t = 1.f - 2.f / (__expf(2.f * y) + 1.f); return 0.5f * x * (1.f + t); }
__device__ __forceinline__ bf16x8 mk8(unsigned a, unsigned b, unsigned c, unsigned d) { u32x4 w = {a, b, c, d}; return __builtin_bit_cast(bf16x8, w); }
__device__ __forceinline__ bf16x8 scale8(bf16x8 v, float s) { u32x4 w = __builtin_bit_cast(u32x4, v);
    return mk8(cvt_pk_bf16(bflo(w.x) * s, bfhi(w.x) * s), cvt_pk_bf16(bflo(w.y) * s, bfhi(w.y) * s), cvt_pk_bf16(bflo(w.z) * s, bfhi(w.z) * s), cvt_pk_bf16(bflo(w.w) * s, bfhi(w.w) * s)); }
#define MFMA16(a, b, c) __builtin_amdgcn_mfma_f32_16x16x32_bf16((a), (b), (c), 0, 0, 0)

template <int ACT> struct EpiBf {
    static constexpr bool PERM = true, AFTER_DRAIN = false;
    bf16_t* base0; bf16_t* base1; int nsplit; int ld;
    __device__ __forceinline__ void operator()(const f32x4 (&acc)[2][2][4][2], const Unit& u, int wr, int wc, int fr, int fq) const {
        bf16_t* base = (u.pn < nsplit) ? base0 + u.pn * 256 : base1 + (u.pn - nsplit) * 256;
        const int row0 = u.pm * 256 + wr * 64 + fr, col0 = wc * 32 + 8 * fq;
#pragma unroll
        for (int ai = 0; ai < 2; ++ai)
#pragma unroll
            for (int m = 0; m < 4; ++m) { bf16_t* rowp = base + (size_t)(row0 + ai * HALF + m * 16) * ld + col0;
#pragma unroll
                for (int bj = 0; bj < 2; ++bj) { f32x4 v0 = acc[ai][bj][m][0], v1 = acc[ai][bj][m][1];
                    if (ACT == 2) { v0 = (f32x4){sigm(v0[0]), sigm(v0[1]), sigm(v0[2]), sigm(v0[3])}; v1 = (f32x4){sigm(v1[0]), sigm(v1[1]), sigm(v1[2]), sigm(v1[3])}; }
                    u32x4 w; w.x = cvt_pk_bf16(v0[0], v0[1]); w.y = cvt_pk_bf16(v0[2], v0[3]); w.z = cvt_pk_bf16(v1[0], v1[1]); w.w = cvt_pk_bf16(v1[2], v1[3]);
                    *(u32x4*)(rowp + bj * HALF) = w; } }
    }
};
struct EpiVT {
    static constexpr bool PERM = true, AFTER_DRAIN = false;
    bf16_t* vtna; bf16_t* vtr;
    __device__ __forceinline__ void operator()(const f32x4 (&acc)[2][2][4][2], const Unit& u, int wr, int wc, int fr, int fq) const {
        bf16_t* base = (u.pm < 2) ? vtna + (size_t)(u.pm * 256) * MTOK : vtr + (size_t)((u.pm - 2) * 256) * MTOK;
        const int row0 = wr * 64 + fr, col0 = u.pn * 256 + wc * 32 + 8 * fq;
#pragma unroll
        for (int ai = 0; ai < 2; ++ai)
#pragma unroll
            for (int m = 0; m < 4; ++m) { bf16_t* rowp = base + (size_t)(row0 + ai * HALF + m * 16) * MTOK + col0;
#pragma unroll
                for (int bj = 0; bj < 2; ++bj) { const f32x4 v0 = acc[ai][bj][m][0], v1 = acc[ai][bj][m][1];
                    u32x4 w; w.x = cvt_pk_bf16(v0[0], v0[1]); w.y = cvt_pk_bf16(v0[2], v0[3]); w.z = cvt_pk_bf16(v1[0], v1[1]); w.w = cvt_pk_bf16(v1[2], v1[3]);
                    *(u32x4*)(rowp + bj * HALF) = w; } }
    }
};
struct EpiProj {
    static constexpr bool PERM = true, AFTER_DRAIN = false;
    bf16_t *qna, *kna, *qr, *kr, *kt, *gr; const float* cosT; const float* sinT;
    __device__ __forceinline__ void operator()(const f32x4 (&acc)[2][2][4][2], const Unit& u, int wr, int wc, int fr, int fq) const {
        const int pn = u.pn, row0 = u.pm * 256 + wr * 64 + fr;
        if (pn < 4 || pn >= 8) {
            bf16_t* base; int ld; float sc = 1.f;
            if (pn < 2) { base = qna + pn * 256; ld = 512; sc = 0.125f; } else if (pn < 4) { base = kna + (pn - 2) * 256; ld = 512; } else { base = gr + (pn - 8) * 256; ld = 1024; }
            const int col0 = wc * 32 + 8 * fq;
#pragma unroll
            for (int ai = 0; ai < 2; ++ai)
#pragma unroll
                for (int m = 0; m < 4; ++m) { bf16_t* rowp = base + (size_t)(row0 + ai * HALF + m * 16) * ld + col0;
#pragma unroll
                    for (int bj = 0; bj < 2; ++bj) { const f32x4 v0 = acc[ai][bj][m][0] * sc, v1 = acc[ai][bj][m][1] * sc;
                        u32x4 w; w.x = cvt_pk_bf16(v0[0], v0[1]); w.y = cvt_pk_bf16(v0[2], v0[3]); w.z = cvt_pk_bf16(v1[0], v1[1]); w.w = cvt_pk_bf16(v1[2], v1[3]);
                        *(u32x4*)(rowp + bj * HALF) = w; } }
        } else {
            const bool isk = pn >= 6; bf16_t* base = isk ? kr : qr; const int hb = (isk ? pn - 6 : pn - 4) * 2;
            const float sc = isk ? 0.08838834764831845f : 1.f;
            const int i4 = 4 * (4 * wc + fq);
#pragma unroll
            for (int ai = 0; ai < 2; ++ai)
#pragma unroll
                for (int m = 0; m < 4; ++m) { const int row = row0 + ai * HALF + m * 16, t = row & (SEQ - 1);
                    const f32x4 c = *(const f32x4*)(cosT + t * 64 + i4), s = *(const f32x4*)(sinT + t * 64 + i4);
#pragma unroll
                    for (int bj = 0; bj < 2; ++bj) { const int head = hb + bj; const f32x4 x1 = acc[ai][bj][m][0], x2 = acc[ai][bj][m][1];
                        const f32x4 o1 = (x1 * c - x2 * s) * sc, o2 = (x2 * c + x1 * s) * sc;
                        u32x2 w1, w2; w1.x = cvt_pk_bf16(o1[0], o1[1]); w1.y = cvt_pk_bf16(o1[2], o1[3]); w2.x = cvt_pk_bf16(o2[0], o2[1]); w2.y = cvt_pk_bf16(o2[2], o2[3]);
                        bf16_t* p = base + (size_t)row * 512 + head * 128 + i4;
                        *(u32x2*)p = w1; *(u32x2*)(p + 64) = w2;
                        if (isk) { bf16_t* q = kt + (size_t)(head * 128 + i4) * MTOK + row;
                            q[0] = (bf16_t)(w1.x & 0xffffu); q[(size_t)MTOK] = (bf16_t)(w1.x >> 16); q[(size_t)2 * MTOK] = (bf16_t)(w1.y & 0xffffu); q[(size_t)3 * MTOK] = (bf16_t)(w1.y >> 16);
                            bf16_t* q2 = q + (size_t)64 * MTOK;
                            q2[0] = (bf16_t)(w2.x & 0xffffu); q2[(size_t)MTOK] = (bf16_t)(w2.x >> 16); q2[(size_t)2 * MTOK] = (bf16_t)(w2.y & 0xffffu); q2[(size_t)3 * MTOK] = (bf16_t)(w2.y >> 16); } } }
        }
    }
};
template <int MODE> struct EpiMerge {
    static constexpr bool PERM = true, AFTER_DRAIN = false;
    bf16_t* mrg; const bf16_t* gate;
    __device__ __forceinline__ void operator()(const f32x4 (&acc)[2][2][4][2], const Unit& u, int wr, int wc, int fr, int fq) const {
        const int row0 = u.pm * 256 + wr * 64 + fr, col0 = u.pn * 256 + wc * 32 + 8 * fq;
#pragma unroll
        for (int ai = 0; ai < 2; ++ai)
#pragma unroll
            for (int m = 0; m < 4; ++m) { const size_t off = (size_t)(row0 + ai * HALF + m * 16) * 1024 + col0;
#pragma unroll
                for (int bj = 0; bj < 2; ++bj) { const f32x4 v0 = acc[ai][bj][m][0], v1 = acc[ai][bj][m][1];
                    const u32x4 g = *(const u32x4*)(gate + off + bj * HALF);
                    float r0 = bflo(g.x) * v0[0], r1 = bfhi(g.x) * v0[1], r2 = bflo(g.y) * v0[2], r3 = bfhi(g.y) * v0[3], r4 = bflo(g.z) * v1[0], r5 = bfhi(g.z) * v1[1], r6 = bflo(g.w) * v1[2], r7 = bfhi(g.w) * v1[3];
                    if (MODE == 1) { const u32x4 p = *(const u32x4*)(mrg + off + bj * HALF);
                        r0 += bflo(p.x); r1 += bfhi(p.x); r2 += bflo(p.y); r3 += bfhi(p.y); r4 += bflo(p.z); r5 += bfhi(p.z); r6 += bflo(p.w); r7 += bfhi(p.w); }
                    u32x4 w; w.x = cvt_pk_bf16(r0, r1); w.y = cvt_pk_bf16(r2, r3); w.z = cvt_pk_bf16(r4, r5); w.w = cvt_pk_bf16(r6, r7);
                    *(u32x4*)(mrg + off + bj * HALF) = w; } }
    }
};
template <int MODE> struct EpiF32 {
    static constexpr bool PERM = false, AFTER_DRAIN = false;
    float* out; const float* res; const bf16_t* sg;
    __device__ __forceinline__ void operator()(const f32x4 (&acc)[2][2][4][2], const Unit& u, int wr, int wc, int fr, int fq) const {
        const int row0 = u.pm * 256 + wr * 64 + fr, col0 = u.pn * 256 + wc * 32 + 4 * fq;
#pragma unroll
        for (int ai = 0; ai < 2; ++ai)
#pragma unroll
            for (int m = 0; m < 4; ++m) { const size_t off = (size_t)(row0 + ai * HALF + m * 16) * 1024 + col0;
#pragma unroll
                for (int bj = 0; bj < 2; ++bj)
#pragma unroll
                    for (int n = 0; n < 2; ++n) { const size_t o = off + bj * HALF + n * 16; const f32x4 a = acc[ai][bj][m][n]; f32x4 r;
                        if (MODE == 0) { r = *(const f32x4*)(res + o) * ALPHA + a; }
                        else if (MODE == 1) { const u32x2 g = *(const u32x2*)(sg + o); const f32x4 gv = {bflo(g.x), bfhi(g.x), bflo(g.y), bfhi(g.y)}; r = *(const f32x4*)(out + o) * ALPHA + gv * a; }
                        else { r = *(const f32x4*)(out + o) + a; }
                        *(f32x4*)(out + o) = r; } }
    }
};

__device__ __forceinline__ float wave_sum(float v) {
#pragma unroll
    for (int o = 1; o < 64; o <<= 1) v += __shfl_xor(v, o);
    return v;
}
__device__ __forceinline__ int rotp(int x) { const int head = x >> 7, d = x & 127, i = (d & 63) >> 2, e = d & 3; return head * 128 + 8 * i + ((d >> 6) << 2) + e; }
__device__ __forceinline__ int map_win(int n) {
    if (n < 1024) return n;
    if (n < 1536) return 3072 + (n - 1024);
    if (n < 2048) return 1024 + rotp(n - 1536);
    if (n < 2560) return 1536 + rotp(n - 2048);
    if (n < 3584) return 3584 + (n - 2560);
    if (n < 4608) return 2048 + (n - 3584);
    return n;
}
__device__ __forceinline__ int map_wup(int n) {
    const bool a = n < 2816; const int j = a ? n : n - 2816;
    if (j < FF1) return (a ? 0 : FF1) + j;
    return 2 * FF1 + (a ? 0 : FF2) + (j - FF1);
}
template <int MAP> __device__ __forceinline__ void transpose_item(const float* W, int N, int k0, int n0, bf16_t* dst, int dstK, int kbase, LAS float* scr, int lane) {
#pragma unroll 8
    for (int i = 0; i < 32; ++i) { const int kk = 2 * i + (lane >> 5); scr[kk * 33 + (lane & 31)] = W[(size_t)(k0 + kk) * N + n0 + (lane & 31)]; }
    asm volatile("s_waitcnt lgkmcnt(0)" ::: "memory");
    const int c = lane & 7;
#pragma unroll
    for (int j = 0; j < 4; ++j) { const int n = (lane >> 3) + 8 * j; const LAS float* s = scr + (8 * c) * 33 + n;
        u32x4 o; o.x = cvt_pk_bf16(s[0 * 33], s[1 * 33]); o.y = cvt_pk_bf16(s[2 * 33], s[3 * 33]); o.z = cvt_pk_bf16(s[4 * 33], s[5 * 33]); o.w = cvt_pk_bf16(s[6 * 33], s[7 * 33]);
        const int sn = n0 + n; const int dr = (MAP == 1) ? map_win(sn) : (MAP == 2) ? map_wup(sn) : sn;
        *(u32x4*)(dst + (size_t)dr * dstK + (k0 - kbase) + 8 * c) = o; }
    asm volatile("s_waitcnt lgkmcnt(0)" ::: "memory");
}
struct In { const float* p[19]; };
__device__ __forceinline__ void convert_layer(const In& in, int layer, bf16_t* Wb, bf16_t* PB, LAS float* scr, int gw, int NGW, int lane) {
    const float* w_in = in.p[2] + (size_t)layer * 1024 * 6656; const float* w_a = in.p[6] + (size_t)layer * 512 * 1024; const float* w_b = in.p[7] + (size_t)layer * 1024 * 1024;
    const float* w_o = in.p[8] + (size_t)layer * 1024 * 1024; const float* w_up = in.p[11] + (size_t)layer * 1024 * 5632; const float* w_dn = in.p[14] + (size_t)layer * 2816 * 1024;
    const float* w_pg = in.p[15] + (size_t)layer * 1024 * 1024; const float* w_pp = in.p[16] + (size_t)layer * 256 * 1024;
    constexpr int I_IN = 16 * 208, I_A = 8 * 32, I_B = 16 * 32, I_O = 16 * 32, I_UP = 16 * 176, I_D1 = 24 * 32, I_D2 = 20 * 32, I_PG = 16 * 32, I_PP = 4 * 32;
    constexpr int NIT = I_IN + I_A + I_B + I_O + I_UP + I_D1 + I_D2 + I_PG + I_PP;
    for (int it = gw; it < NIT; it += NGW) {
        int r = it;
        if (r < I_IN) { transpose_item<1>(w_in, 6656, 64 * (r / 208), 32 * (r % 208), Wb + W_IN, 1024, 0, scr, lane); continue; } r -= I_IN;
        if (r < I_A) { transpose_item<0>(w_a, 1024, 64 * (r / 32), 32 * (r % 32), Wb + W_A, 512, 0, scr, lane); continue; } r -= I_A;
        if (r < I_B) { transpose_item<0>(w_b, 1024, 64 * (r / 32), 32 * (r % 32), Wb + W_B, 1024, 0, scr, lane); continue; } r -= I_B;
        if (r < I_O) { transpose_item<0>(w_o, 1024, 64 * (r / 32), 32 * (r % 32), Wb + W_O, 1024, 0, scr, lane); continue; } r -= I_O;
        if (r < I_UP) { transpose_item<2>(w_up, 5632, 64 * (r / 176), 32 * (r % 176), Wb + W_UP, 1024, 0, scr, lane); continue; } r -= I_UP;
        if (r < I_D1) { transpose_item<0>(w_dn, 1024, 64 * (r / 32), 32 * (r % 32), Wb + W_D1, FF1, 0, scr, lane); continue; } r -= I_D1;
        if (r < I_D2) { transpose_item<0>(w_dn, 1024, FF1 + 64 * (r / 32), 32 * (r % 32), Wb + W_D2, FF2, FF1, scr, lane); continue; } r -= I_D2;
        if (r < I_PG) { transpose_item<0>(w_pg, 1024, 64 * (r / 32), 32 * (r % 32), Wb + W_PG, 1024, 0, scr, lane); continue; } r -= I_PG;
        transpose_item<0>(w_pp, 1024, 64 * (r / 32), 32 * (r % 32), Wb + W_PP, 256, 0, scr, lane);
    }
    const float* ps = in.p[1] + (size_t)layer * MTOK * 256;
    for (int i = gw; i < MTOK * 256 / 512; i += NGW) { const size_t e = (size_t)i * 512 + lane * 8; const f32x4 a = *(const f32x4*)(ps + e), b = *(const f32x4*)(ps + e + 4);
        u32x4 w; w.x = cvt_pk_bf16(a[0], a[1]); w.y = cvt_pk_bf16(a[2], a[3]); w.z = cvt_pk_bf16(b[0], b[1]); w.w = cvt_pk_bf16(b[2], b[3]); *(u32x4*)(PB + e) = w; }
}
__device__ __forceinline__ void ln_row(const float* src, float* dst, bf16_t* xb, const float* g, const float* b, int lane) {
    const f32x4* xr = (const f32x4*)src + lane; f32x4 v[4]; float s = 0.f;
#pragma unroll
    for (int j = 0; j < 4; ++j) { v[j] = xr[64 * j]; s += (v[j][0] + v[j][1]) + (v[j][2] + v[j][3]); }
    const float mean = wave_sum(s) * (1.f / DM); float s2 = 0.f;
#pragma unroll
    for (int j = 0; j < 4; ++j) { v[j] = v[j] - mean; s2 += (v[j][0] * v[j][0] + v[j][1] * v[j][1]) + (v[j][2] * v[j][2] + v[j][3] * v[j][3]); }
    const float rstd = 1.f / sqrtf(wave_sum(s2) * (1.f / DM) + LN_EPS);
#pragma unroll
    for (int j = 0; j < 4; ++j) { const f32x4 gg = ((const f32x4*)g)[lane + 64 * j], bb = ((const f32x4*)b)[lane + 64 * j]; const f32x4 o = v[j] * rstd * gg + bb;
        ((f32x4*)dst)[lane + 64 * j] = o; u32x2 w; w.x = cvt_pk_bf16(o[0], o[1]); w.y = cvt_pk_bf16(o[2], o[3]); ((u32x2*)xb)[lane + 64 * j] = w; }
}

__device__ __forceinline__ void na_phase(bf16_t* QNA, const bf16_t* KNA, const bf16_t* VT, const float* rpb, LAS float* ldsf, int tid, int wave, int lane, int bid) {
    for (int i = tid; i < 8 * 465; i += 512) ldsf[i] = rpb[i];
    __syncthreads();
    const int fr = lane & 15, fq = lane >> 4;
    for (int unit = bid * 8 + wave; unit < 16384; unit += gridDim.x * 8) {
        const int j = unit & 3, h = (unit >> 2) & 7, r = (unit >> 5) & 127, b = unit >> 12;
        const int tq = b * SEQ + r * 64 + 16 * j;
        const int rs = min(max(r - 4, 0), 120), c0 = min(max(16 * j - 8, 0), 32);
        const int qcol = 16 * j + fr, cs = min(max(qcol - 8, 0), 48);
        bf16_t* qp = QNA + (size_t)(tq + fr) * 512 + h * 64;
        const bf16x8 qf0 = *(const bf16x8*)(qp + 8 * fq), qf1 = *(const bf16x8*)(qp + 32 + 8 * fq);
        f32x4 s[16]; float mx = -INFINITY;
#pragma unroll
        for (int a = 0; a < 16; ++a) { const int kr = a >> 1, kc0 = (a & 1) * 16;
            const bf16_t* kp = KNA + (size_t)(b * SEQ + (rs + kr) * 64 + c0 + kc0 + fr) * 512 + h * 64 + 8 * fq;
            const bf16x8 kf0 = *(const bf16x8*)kp, kf1 = *(const bf16x8*)(kp + 32);
            f32x4 acc = {0.f, 0.f, 0.f, 0.f}; acc = MFMA16(kf0, qf0, acc); acc = MFMA16(kf1, qf1, acc);
            const LAS float* bp = ldsf + h * 465 + (rs + kr - r + 7) * 31;
#pragma unroll
            for (int v = 0; v < 4; ++v) { const int kcol = c0 + kc0 + 4 * fq + v; const bool valid = (kcol >= cs) && (kcol < cs + 16);
                const int bi = min(max(kcol - qcol + 15, 0), 30);
                const float sv = valid ? acc[v] + bp[bi] : -INFINITY; s[a][v] = sv; mx = fmaxf(mx, sv); } }
        mx = fmaxf(mx, __shfl_xor(mx, 16)); mx = fmaxf(mx, __shfl_xor(mx, 32));
        float l = 0.f;
#pragma unroll
        for (int a = 0; a < 16; ++a)
#pragma unroll
            for (int v = 0; v < 4; ++v) { const float p = __expf(s[a][v] - mx); s[a][v] = p; l += p; }
        l += __shfl_xor(l, 16); l += __shfl_xor(l, 32);
        const float rl = 1.f / l;
        f32x4 o[4];
#pragma unroll
        for (int dt = 0; dt < 4; ++dt) o[dt] = (f32x4){0.f, 0.f, 0.f, 0.f};
#pragma unroll
        for (int ks = 0; ks < 8; ++ks) {
            const bf16x8 pf = mk8(cvt_pk_bf16(s[2 * ks][0], s[2 * ks][1]), cvt_pk_bf16(s[2 * ks][2], s[2 * ks][3]), cvt_pk_bf16(s[2 * ks + 1][0], s[2 * ks + 1][1]), cvt_pk_bf16(s[2 * ks + 1][2], s[2 * ks + 1][3]));
            const size_t tk = (size_t)b * SEQ + (rs + ks) * 64 + c0 + 4 * fq;
#pragma unroll
            for (int dt = 0; dt < 4; ++dt) { const bf16_t* vp = VT + (size_t)(h * 64 + 16 * dt + fr) * MTOK + tk;
                const u32x2 lo = *(const u32x2*)vp, hi = *(const u32x2*)(vp + 16);
                o[dt] = MFMA16(mk8(lo.x, lo.y, hi.x, hi.y), pf, o[dt]); } }
#pragma unroll
        for (int dt = 0; dt < 4; ++dt) { u32x2 w; w.x = cvt_pk_bf16(o[dt][0] * rl, o[dt][1] * rl); w.y = cvt_pk_bf16(o[dt][2] * rl, o[dt][3] * rl);
            *(u32x2*)(qp + 16 * dt + 4 * fq) = w; }
    }
    __syncthreads();
}

__device__ __forceinline__ void ret_kv_phase(const bf16_t* KT, const bf16_t* VT, bf16_t* ST, const float* dec_f, const float* dec_b, int wave, int lane, int bid) {
    const int fr = lane & 15, fq = lane >> 4;
    for (int unit = bid; unit < 512; unit += gridDim.x) {
        const int c = unit & 31, bh = unit >> 5, h = bh & 3, b = bh >> 2;
        const size_t tok0 = (size_t)b * SEQ + c * 256;
        const float lgf = log2f(1.f / (1.f + expf(-dec_f[h]))), lgb = log2f(1.f / (1.f + expf(-dec_b[h])));
        f32x4 af[16], ab[16];
#pragma unroll
        for (int dt = 0; dt < 16; ++dt) { af[dt] = (f32x4){0.f, 0.f, 0.f, 0.f}; ab[dt] = (f32x4){0.f, 0.f, 0.f, 0.f}; }
        const bf16_t* kp = KT + (size_t)(h * 128 + 16 * wave + fr) * MTOK + tok0 + 8 * fq;
        const bf16_t* vp = VT + (size_t)(h * 256 + fr) * MTOK + tok0 + 8 * fq;
#pragma unroll 1
        for (int s = 0; s < 8; ++s) {
            const u32x4 kw = *(const u32x4*)(kp + 32 * s);
            const int j0 = 32 * s + 8 * fq;
            float zf[8], zb[8];
#pragma unroll
            for (int e = 0; e < 8; ++e) { zf[e] = exp2f(lgf * (float)(255 - j0 - e)); zb[e] = exp2f(lgb * (float)(j0 + e)); }
            const bf16x8 kf = mk8(cvt_pk_bf16(bflo(kw.x) * zf[0], bfhi(kw.x) * zf[1]), cvt_pk_bf16(bflo(kw.y) * zf[2], bfhi(kw.y) * zf[3]), cvt_pk_bf16(bflo(kw.z) * zf[4], bfhi(kw.z) * zf[5]), cvt_pk_bf16(bflo(kw.w) * zf[6], bfhi(kw.w) * zf[7]));
            const bf16x8 kb = mk8(cvt_pk_bf16(bflo(kw.x) * zb[0], bfhi(kw.x) * zb[1]), cvt_pk_bf16(bflo(kw.y) * zb[2], bfhi(kw.y) * zb[3]), cvt_pk_bf16(bflo(kw.z) * zb[4], bfhi(kw.z) * zb[5]), cvt_pk_bf16(bflo(kw.w) * zb[6], bfhi(kw.w) * zb[7]));
#pragma unroll
            for (int dt = 0; dt < 16; ++dt) { const bf16x8 vf = *(const bf16x8*)(vp + (size_t)(16 * dt) * MTOK + 32 * s);
                af[dt] = MFMA16(kf, vf, af[dt]); ab[dt] = MFMA16(kb, vf, ab[dt]); }
        }
        bf16_t* sf = ST + ((size_t)(bh * 32 + c) * 2) * 32768 + 16 * wave + 4 * fq;
#pragma unroll
        for (int dt = 0; dt < 16; ++dt) { u32x2 w; w.x = cvt_pk_bf16(af[dt][0], af[dt][1]); w.y = cvt_pk_bf16(af[dt][2], af[dt][3]); *(u32x2*)(sf + (size_t)(16 * dt + fr) * 128) = w;
            u32x2 x; x.x = cvt_pk_bf16(ab[dt][0], ab[dt][1]); x.y = cvt_pk_bf16(ab[dt][2], ab[dt][3]); *(u32x2*)(sf + 32768 + (size_t)(16 * dt + fr) * 128) = x; }
    }
}
__device__ __forceinline__ void ret_scan_phase(bf16_t* ST, const float* dec_f, const float* dec_b, int tid, int bid) {
    for (int g = bid * 512 + tid; g < 131072; g += gridDim.x * 512) {
        const int e8 = g & 4095, bhd = g >> 12, dir = bhd & 1, bh = bhd >> 1, h = bh & 3;
        const float lg = log2f(1.f / (1.f + expf(-(dir ? dec_b[h] : dec_f[h])))); const float dec = exp2f(256.f * lg);
        bf16_t* base = ST + ((size_t)(bh * 32) * 2 + dir) * 32768 + (size_t)e8 * 8;
        u32x4 v[32];
#pragma unroll
        for (int it = 0; it < 32; ++it) { const int c = dir ? 31 - it : it; v[it] = *(const u32x4*)(base + (size_t)c * 65536); }
        float S[8];
#pragma unroll
        for (int e = 0; e < 8; ++e) S[e] = 0.f;
#pragma unroll
        for (int it = 0; it < 32; ++it) { const int c = dir ? 31 - it : it;
            u32x4 w; w.x = cvt_pk_bf16(S[0], S[1]); w.y = cvt_pk_bf16(S[2], S[3]); w.z = cvt_pk_bf16(S[4], S[5]); w.w = cvt_pk_bf16(S[6], S[7]);
            *(u32x4*)(base + (size_t)c * 65536) = w;
            S[0] = S[0] * dec + bflo(v[it].x); S[1] = S[1] * dec + bfhi(v[it].x); S[2] = S[2] * dec + bflo(v[it].y); S[3] = S[3] * dec + bfhi(v[it].y);
            S[4] = S[4] * dec + bflo(v[it].z); S[5] = S[5] * dec + bfhi(v[it].z); S[6] = S[6] * dec + bflo(v[it].w); S[7] = S[7] * dec + bfhi(v[it].w); }
    }
}
__device__ __forceinline__ void ret_out_phase(const bf16_t* QR, const bf16_t* KR, const bf16_t* VT, const bf16_t* ST, bf16_t* GR, const float* dec_f, const float* dec_b, LAS unsigned char* ldsb, int wave, int lane, int bid) {
    const int fr = lane & 15, fq = lane >> 4;
    for (int unit = bid; unit < 512; unit += gridDim.x) {
        const int c = unit & 31, bh = unit >> 5, h = bh & 3, b = bh >> 2;
        const size_t tok0 = (size_t)b * SEQ + c * 256;
        const float lgf = log2f(1.f / (1.f + expf(-dec_f[h]))), lgb = log2f(1.f / (1.f + expf(-dec_b[h])));
        LAS bf16x8* qL = (LAS bf16x8*)(ldsb + wave * 8192) + lane;
#pragma unroll
        for (int mi = 0; mi < 2; ++mi)
#pragma unroll
            for (int ks = 0; ks < 4; ++ks) qL[(mi * 4 + ks) * 64] = *(const bf16x8*)(QR + (tok0 + 32 * wave + 16 * mi + fr) * 512 + h * 128 + 32 * ks + 8 * fq);
#define QF(mi, ks) (qL[((mi) * 4 + (ks)) * 64])
        f32x4 acc[16][2];
#pragma unroll
        for (int dt = 0; dt < 16; ++dt) { acc[dt][0] = (f32x4){0.f, 0.f, 0.f, 0.f}; acc[dt][1] = (f32x4){0.f, 0.f, 0.f, 0.f}; }
        const bf16_t* vbase = VT + (size_t)(h * 256 + fr) * MTOK + tok0 + 4 * fq;
#pragma unroll 1
        for (int s = 0; s < 8; ++s) {
            asm volatile("" ::: "memory");
            f32x4 st[2][2];
#pragma unroll
            for (int a01 = 0; a01 < 2; ++a01) { st[a01][0] = (f32x4){0.f, 0.f, 0.f, 0.f}; st[a01][1] = (f32x4){0.f, 0.f, 0.f, 0.f};
                const bf16_t* kp = KR + (tok0 + 32 * s + 16 * a01 + fr) * 512 + h * 128 + 8 * fq;
#pragma unroll
                for (int ks = 0; ks < 4; ++ks) { const bf16x8 kf = *(const bf16x8*)(kp + 32 * ks);
                    st[a01][0] = MFMA16(kf, QF(0, ks), st[a01][0]); st[a01][1] = MFMA16(kf, QF(1, ks), st[a01][1]); }
#pragma unroll
                for (int mi = 0; mi < 2; ++mi)
#pragma unroll
                    for (int v = 0; v < 4; ++v) { const int d = (32 * wave + 16 * mi + fr) - (32 * s + 16 * a01 + 4 * fq + v);
                        st[a01][mi][v] *= exp2f(d >= 0 ? lgf * (float)d : lgb * (float)(-d)); } }
            const bf16x8 pf0 = mk8(cvt_pk_bf16(st[0][0][0], st[0][0][1]), cvt_pk_bf16(st[0][0][2], st[0][0][3]), cvt_pk_bf16(st[1][0][0], st[1][0][1]), cvt_pk_bf16(st[1][0][2], st[1][0][3]));
            const bf16x8 pf1 = mk8(cvt_pk_bf16(st[0][1][0], st[0][1][1]), cvt_pk_bf16(st[0][1][2], st[0][1][3]), cvt_pk_bf16(st[1][1][0], st[1][1][1]), cvt_pk_bf16(st[1][1][2], st[1][1][3]));
#pragma unroll
            for (int dt = 0; dt < 16; ++dt) { const bf16_t* vp = vbase + (size_t)(16 * dt) * MTOK + 32 * s;
                const u32x2 lo = *(const u32x2*)vp, hi = *(const u32x2*)(vp + 16); const bf16x8 vf = mk8(lo.x, lo.y, hi.x, hi.y);
                acc[dt][0] = MFMA16(vf, pf0, acc[dt][0]); acc[dt][1] = MFMA16(vf, pf1, acc[dt][1]); if ((dt & 3) == 3) __builtin_amdgcn_sched_barrier(0); }
        }
#pragma unroll 1
        for (int dir = 0; dir < 2; ++dir) {
            const bf16_t* sp = ST + ((size_t)(bh * 32 + c) * 2 + dir) * 32768 + (size_t)fr * 128 + 8 * fq;
            const int i0 = 32 * wave + fr;
            const float sc0 = dir ? exp2f(lgb * (float)(256 - i0)) : exp2f(lgf * (float)(i0 + 1));
            const float sc1 = dir ? exp2f(lgb * (float)(256 - i0 - 16)) : exp2f(lgf * (float)(i0 + 17));
#pragma unroll
            for (int ks = 0; ks < 4; ++ks) { asm volatile("" ::: "memory"); const bf16x8 qs0 = scale8(QF(0, ks), sc0), qs1 = scale8(QF(1, ks), sc1);
#pragma unroll
                for (int dt = 0; dt < 16; ++dt) { const bf16x8 sf = *(const bf16x8*)(sp + (size_t)(16 * dt) * 128 + 32 * ks);
                    acc[dt][0] = MFMA16(sf, qs0, acc[dt][0]); acc[dt][1] = MFMA16(sf, qs1, acc[dt][1]); if ((dt & 3) == 3) __builtin_amdgcn_sched_barrier(0); } }
        }
#pragma unroll
        for (int mi = 0; mi < 2; ++mi) {
            float sm = 0.f;
#pragma unroll
            for (int dt = 0; dt < 16; ++dt) sm += (acc[dt][mi][0] + acc[dt][mi][1]) + (acc[dt][mi][2] + acc[dt][mi][3]);
            sm += __shfl_xor(sm, 16); sm += __shfl_xor(sm, 32);
            const float mu = sm * (1.f / 256.f); float sq = 0.f;
#pragma unroll
            for (int dt = 0; dt < 16; ++dt) { const f32x4 d = acc[dt][mi] - mu; sq += (d[0] * d[0] + d[1] * d[1]) + (d[2] * d[2] + d[3] * d[3]); }
            sq += __shfl_xor(sq, 16); sq += __shfl_xor(sq, 32);
            const float rstd = 1.f / sqrtf(sq * (1.f / 256.f) + GN_EPS);
            bf16_t* gp = GR + (tok0 + 32 * wave + 16 * mi + fr) * 1024 + h * 256 + 4 * fq;
#pragma unroll
            for (int dt = 0; dt < 16; ++dt) { const u32x2 gw = *(const u32x2*)(gp + 16 * dt);
                const float g0 = bflo(gw.x), g1 = bfhi(gw.x), g2 = bflo(gw.y), g3 = bfhi(gw.y); const f32x4 o = (acc[dt][mi] - mu) * rstd;
                u32x2 w; w.x = cvt_pk_bf16(g0 * sigm(g0) * o[0], g1 * sigm(g1) * o[1]); w.y = cvt_pk_bf16(g2 * sigm(g2) * o[2], g3 * sigm(g3) * o[3]);
                *(u32x2*)(gp + 16 * dt) = w; }
        }
    }
}
#undef QF
__device__ __forceinline__ void conv_glu_phase(const bf16_t* H, bf16_t* U, int NP, int aoff, const float* cw, const float* cb, int tid, int bid) {
    const int ncg = NP / 8, nitems = (MTOK / 32) * ncg;
    for (int item = bid * 512 + tid; item < nitems; item += gridDim.x * 512) {
        const int cgp = item % ncg, strip = item / ncg, j0 = cgp * 8, t0 = strip * 32;
        float wa[3][8], wb[3][8], ba[8], bb[8];
#pragma unroll
        for (int e = 0; e < 8; ++e) {
#pragma unroll
            for (int k = 0; k < 3; ++k) { wa[k][e] = cw[k * 5632 + aoff + j0 + e]; wb[k][e] = cw[k * 5632 + 2816 + aoff + j0 + e]; }
            ba[e] = cb[aoff + j0 + e]; bb[e] = cb[2816 + aoff + j0 + e]; }
        const bf16_t* hp = H + (size_t)t0 * (2 * NP) + j0;
        u32x4 pa, pb, ca, cb_, na, nb;
        const u32x4 z4 = {0u, 0u, 0u, 0u};
        if ((t0 & (SEQ - 1)) != 0) { pa = *(const u32x4*)(hp - (size_t)(2 * NP)); pb = *(const u32x4*)(hp - (size_t)(2 * NP) + NP); } else { pa = z4; pb = z4; }
        ca = *(const u32x4*)hp; cb_ = *(const u32x4*)(hp + NP);
#pragma unroll 1
        for (int r = 0; r < 32; ++r) {
            const int t = t0 + r;
            if ((t & (SEQ - 1)) != SEQ - 1) { na = *(const u32x4*)(hp + (size_t)(r + 1) * (2 * NP)); nb = *(const u32x4*)(hp + (size_t)(r + 1) * (2 * NP) + NP); } else { na = z4; nb = z4; }
            float o[8];
#define CG_ONE(e, PW, CW, NW, PWB, CWB, NWB, LOHI) { const float a = wa[0][e] * LOHI(PW) + wa[1][e] * LOHI(CW) + wa[2][e] * LOHI(NW) + ba[e]; \
                const float bq = wb[0][e] * LOHI(PWB) + wb[1][e] * LOHI(CWB) + wb[2][e] * LOHI(NWB) + bb[e]; o[e] = gelu_tanh(a) * bq; }
            CG_ONE(0, pa.x, ca.x, na.x, pb.x, cb_.x, nb.x, bflo) CG_ONE(1, pa.x, ca.x, na.x, pb.x, cb_.x, nb.x, bfhi)
            CG_ONE(2, pa.y, ca.y, na.y, pb.y, cb_.y, nb.y, bflo) CG_ONE(3, pa.y, ca.y, na.y, pb.y, cb_.y, nb.y, bfhi)
            CG_ONE(4, pa.z, ca.z, na.z, pb.z, cb_.z, nb.z, bflo) CG_ONE(5, pa.z, ca.z, na.z, pb.z, cb_.z, nb.z, bfhi)
            CG_ONE(6, pa.w, ca.w, na.w, pb.w, cb_.w, nb.w, bflo) CG_ONE(7, pa.w, ca.w, na.w, pb.w, cb_.w, nb.w, bfhi)
#undef CG_ONE
            u32x4 w; w.x = cvt_pk_bf16(o[0], o[1]); w.y = cvt_pk_bf16(o[2], o[3]); w.z = cvt_pk_bf16(o[4], o[5]); w.w = cvt_pk_bf16(o[6], o[7]);
            *(u32x4*)(U + (size_t)t * NP + j0) = w;
            pa = ca; pb = cb_; ca = na; cb_ = nb;
        }
    }
}

#ifndef PH_MASK
#define PH_MASK 0xFFFFFFFFu
#endif
#define PH(n) ((PH_MASK >> (n)) & 1u)
struct Args { const float* in[19]; float* out; unsigned char* ws; };
constexpr int LDS_BYTES = 147456;
__device__ __forceinline__ int otid() { int t = threadIdx.x; asm volatile("" : "+v"(t)); return t; }
__device__ __forceinline__ int obid() { int b = blockIdx.x; asm volatile("" : "+s"(b)); return b; }
typedef const unsigned long long __attribute__((address_space(4)))* kptr_t;
__device__ __forceinline__ kptr_t kargs_() { kptr_t p = (kptr_t)__builtin_amdgcn_kernarg_segment_ptr(); asm volatile("" : "+s"(p)); return p; }
#define KIN(k) ((const float*)kargs_()[k])
#define KOUT ((float*)kargs_()[19])
#define KWS ((unsigned char*)kargs_()[20])
#define LOADIN(in) In in; { kptr_t kp_ = kargs_(); _Pragma("unroll") for (int i_ = 0; i_ < 19; ++i_) in.p[i_] = (const float*)kp_[i_]; }
#define TSET const int tid = otid(), lane = tid & 63, wave = __builtin_amdgcn_readfirstlane(tid >> 6), bid = obid(), gw = bid * 8 + wave, NGW = (int)gridDim.x * 8; (void)lane; (void)gw; (void)NGW; (void)tid;
#define GEMM(EpiT, Aptr, Bptr, Mv, Nv, Kv, Eobj) do { Gemm g_{(const bf16_t*)(Aptr), (const bf16_t*)(Bptr), (Mv), (Nv), (Kv)}; StaticOrder S_; S_.init((Mv), (Nv), (int)gridDim.x, obid()); \
        gemm_phase<EpiT, StaticOrder, true, true>(ldsp, g_, S_, (Eobj)); } while (0)
#define PHASE_FENCE() do { __builtin_amdgcn_fence(__ATOMIC_RELEASE, "agent"); __builtin_amdgcn_fence(__ATOMIC_ACQUIRE, "agent"); __syncthreads(); } while (0)


#define RLX_AGENT __ATOMIC_RELAXED, __HIP_MEMORY_SCOPE_AGENT
#define XB_TMO      128
#define XB_XCNT(j)  (256  + 64 * (j))
#define XB_XSUB(j)  (1280 + 64 * (j))
#define XB_XGEN(j)  (2304 + 64 * (j))
#define XB_TOP      3328
#define XB_TOPGEN   3392
#define XCD_BAR_WORDS 3456
#define XB_SPIN_CAP (1u << 18)

__device__ __forceinline__ unsigned xb_ld(unsigned* p)              { return __hip_atomic_load(p, __ATOMIC_RELAXED, __HIP_MEMORY_SCOPE_AGENT); }
__device__ __forceinline__ unsigned xb_add(unsigned* p, unsigned v) { return __hip_atomic_fetch_add(p, v, __ATOMIC_RELAXED, __HIP_MEMORY_SCOPE_AGENT); }
__device__ __forceinline__ unsigned xb_xcc_id() { return (unsigned)__builtin_amdgcn_s_getreg((3 << 11) | 20) & 0xFu; }
#define XB_SPIN(cond, bar) do { unsigned _sp = 0; while (cond) { __builtin_amdgcn_s_sleep(1); \
    if ((++_sp & 255u) == 0u) { if (xb_ld(&(bar)[XB_TMO])) break; if (_sp > XB_SPIN_CAP) { atomicAdd(&(bar)[XB_TMO], 1u); break; } } } } while (0)

struct XcdBarrier {
    unsigned* bar; unsigned x;
    volatile LAS unsigned* st;
};

__device__ __forceinline__ XcdBarrier xcd_barrier_post(unsigned* bar, volatile LAS unsigned* st) {
    XcdBarrier b; b.bar = bar; b.x = xb_xcc_id(); b.st = st;
    if (threadIdx.x == 0) (void)xb_add(&bar[XB_XCNT(b.x)], 1u);
    return b;
}
__device__ __forceinline__ void xcd_barrier_complete(unsigned* bar, unsigned x, unsigned& nloc, unsigned& nx) {
    const unsigned G = gridDim.x * gridDim.y * gridDim.z;
    unsigned sum, cnt, mine, sp = 0u;
    for (;;) {
        sum = 0u; cnt = 0u; mine = 0u;
#pragma unroll
        for (unsigned j = 0; j < 16; ++j) { const unsigned c = xb_ld(&bar[XB_XCNT(j)]); sum += c; cnt += (c > 0u) ? 1u : 0u; mine = (j == x) ? c : mine; }
        if (sum == G) break;
        __builtin_amdgcn_s_sleep(1);
        if ((++sp & 255u) == 0u) { if (xb_ld(&bar[XB_TMO])) break; if (sp > XB_SPIN_CAP) { atomicAdd(&bar[XB_TMO], 1u); break; } }
    }
    nloc = mine > 0u ? mine : 1u; nx = cnt > 0u ? cnt : 1u;
}

__device__ __forceinline__ void xcd_barrier(const XcdBarrier& b) {
    asm volatile("s_waitcnt vmcnt(0)" ::: "memory");
    __syncthreads();
    if (threadIdx.x == 0) {
        unsigned* bar = b.bar;
        __builtin_amdgcn_s_waitcnt(0);
        unsigned nloc = b.st[0], nx = b.st[1];
        if (nloc == 0u) { xcd_barrier_complete(bar, b.x, nloc, nx); b.st[0] = nloc; b.st[1] = nx; }
        const unsigned old = xb_add(&bar[XB_XSUB(b.x)], 1u);
        const unsigned gen = old / nloc;
        if (old + 1u == (gen + 1u) * nloc) {
            __builtin_amdgcn_fence(__ATOMIC_RELEASE, "agent");
            asm volatile("s_waitcnt vmcnt(0)" ::: "memory");
            const unsigned og = xb_add(&bar[XB_TOP], 1u);
            const unsigned tg = og / nx;
            if (og + 1u == (tg + 1u) * nx) xb_add(&bar[XB_TOPGEN], 1u);
            else XB_SPIN(xb_ld(&bar[XB_TOPGEN]) == tg, bar);
            __builtin_amdgcn_fence(__ATOMIC_ACQUIRE, "agent");
            xb_add(&bar[XB_XGEN(b.x)], 1u);
            asm volatile("s_waitcnt vmcnt(0)" ::: "memory");
        } else {
            XB_SPIN(xb_ld(&bar[XB_XGEN(b.x)]) == gen, bar);
            __builtin_amdgcn_fence(__ATOMIC_ACQUIRE, "agent");
            asm volatile("s_waitcnt vmcnt(0)" ::: "memory");
        }
    }
    __syncthreads();
}

#define XBAR() do { XcdBarrier b_; b_.bar = (unsigned*)KWS; b_.x = xb_xcc_id(); b_.st = (volatile LAS unsigned*)(lds + 131072 + 2048); xcd_barrier(b_); } while (0)

#ifndef PROBE_SEL
#define PROBE_SEL 0u
#endif
#ifndef PROBE_K
#define PROBE_K 8
#endif
#define STAMP(cat) do { if (PROBE_SEL != 0u) { if (blockIdx.x == 0 && threadIdx.x == 0) { volatile LAS unsigned long long* tw_ = (volatile LAS unsigned long long*)(lds + 131072 + 1024); \
        const unsigned long long t_ = __builtin_amdgcn_s_memrealtime(); if ((PROBE_SEL >> (cat)) & 1u) tw_[1] += t_ - tw_[0]; tw_[0] = t_; } } } while (0)
#define SYNC() do { XBAR(); STAMP(15); } while (0)
#define P_(off) ((bf16_t*)(KWS + (off)))
#define cosT ((float*)(KWS + WS_COS))
#define sinT ((float*)(KWS + WS_SIN))
#define Wb P_(WS_W)
#define xout KOUT
template <int layer> __device__ __forceinline__ void layer_body(unsigned char* lds, PG8_LAS unsigned char* ldsp, cg::grid_group& grid) {
        if (PH(1)) { EpiProj E{P_(WS_QNA), P_(WS_KNA), P_(WS_QR), P_(WS_KR), P_(WS_KT), P_(WS_GR), cosT, sinT}; GEMM(EpiProj, P_(WS_XB), Wb + W_IN, MTOK, 3072, 1024, E); }
        STAMP(1);
        __syncthreads();
        if (PH(2)) { EpiVT E{P_(WS_VTNA), P_(WS_VTR)}; GEMM(EpiVT, Wb + W_IN + (size_t)3072 * 1024, P_(WS_XB), 1536, MTOK, 1024, E); }
        STAMP(1);
        SYNC();
        if (PH(3)) { TSET ret_kv_phase(P_(WS_KT), P_(WS_VTR), P_(WS_ST), KIN(4) + layer * 4, KIN(5) + layer * 4, wave, lane, bid); }
        STAMP(2);
        __syncthreads();
        if (PH(4)) { TSET na_phase(P_(WS_QNA), P_(WS_KNA), P_(WS_VTNA), KIN(3) + layer * 3720, (LAS float*)lds, tid, wave, lane, bid); }
        STAMP(3);
        SYNC();
        if (PH(5)) { TSET ret_scan_phase(P_(WS_ST), KIN(4) + layer * 4, KIN(5) + layer * 4, tid, bid); }
        STAMP(4);
        SYNC();
        if (PH(6)) { TSET ret_out_phase(P_(WS_QR), P_(WS_KR), P_(WS_VTR), P_(WS_ST), P_(WS_GR), KIN(4) + layer * 4, KIN(5) + layer * 4, (LAS unsigned char*)lds, wave, lane, bid); }
        STAMP(5);
        __syncthreads();
        if (PH(7)) { EpiBf<2> E{P_(WS_GA), P_(WS_GB), 4, 1024}; GEMM(EpiBf<2>, P_(WS_XB), Wb + W_IN + (size_t)4608 * 1024, MTOK, 2048, 1024, E); }
        STAMP(6);
        SYNC();
        if (PH(8)) { EpiMerge<0> E{P_(WS_MRG), P_(WS_GA)}; GEMM(EpiMerge<0>, P_(WS_QNA), Wb + W_A, MTOK, 1024, 512, E); }
        STAMP(7);
        PHASE_FENCE();
        if (PH(9)) { EpiMerge<1> E{P_(WS_MRG), P_(WS_GB)}; GEMM(EpiMerge<1>, P_(WS_GR), Wb + W_B, MTOK, 1024, 1024, E); }
        STAMP(7);
        SYNC();
        if (PH(10)) { EpiF32<0> E{xout, layer == 0 ? KIN(0) : xout, nullptr}; GEMM(EpiF32<0>, P_(WS_MRG), Wb + W_O, MTOK, 1024, 1024, E); }
        STAMP(7);
        SYNC();
        if (PH(11)) { TSET for (int m = gw; m < MTOK; m += NGW) ln_row(xout + (size_t)m * DM, xout + (size_t)m * DM, P_(WS_XB) + (size_t)m * DM, KIN(9) + layer * DM, KIN(10) + layer * DM, lane); }
        STAMP(8);
        SYNC();
        if (PH(12)) { EpiBf<0> E{P_(WS_H), P_(WS_H), 1 << 20, 2 * FF1}; GEMM(EpiBf<0>, P_(WS_XB), Wb + W_UP, MTOK, 2 * FF1, 1024, E); }
        STAMP(9);
        __syncthreads();
        if (PH(13)) { EpiBf<2> E{P_(WS_SG), P_(WS_SG), 1 << 20, 1024}; GEMM(EpiBf<2>, P_(WS_XB), Wb + W_PG, MTOK, 1024, 1024, E); }
        STAMP(9);
        PHASE_FENCE();
        if (PH(14)) { EpiF32<1> E{xout, nullptr, P_(WS_SG)}; GEMM(EpiF32<1>, P_(WS_PB), Wb + W_PP, MTOK, 1024, 256, E); }
        STAMP(9);
        SYNC();
        if (PH(15)) { TSET conv_glu_phase(P_(WS_H), P_(WS_U), FF1, 0, KIN(12) + (size_t)layer * 3 * 5632, KIN(13) + (size_t)layer * 5632, tid, bid); }
        STAMP(10);
        SYNC();
        if (PH(16)) { EpiF32<2> E{xout, nullptr, nullptr}; GEMM(EpiF32<2>, P_(WS_U), Wb + W_D1, MTOK, 1024, FF1, E); }
        STAMP(11);
        __syncthreads();
        if (PH(17)) { EpiBf<0> E{P_(WS_H), P_(WS_H), 1 << 20, 2 * FF2}; GEMM(EpiBf<0>, P_(WS_XB), Wb + W_UP + (size_t)(2 * FF1) * 1024, MTOK, 2 * FF2, 1024, E); }
        STAMP(11);
        SYNC();
        if (PH(18)) { TSET conv_glu_phase(P_(WS_H), P_(WS_U), FF2, FF1, KIN(12) + (size_t)layer * 3 * 5632, KIN(13) + (size_t)layer * 5632, tid, bid); }
        STAMP(10);
        SYNC();
        if (PH(19)) { EpiF32<2> E{xout, nullptr, nullptr}; GEMM(EpiF32<2>, P_(WS_U), Wb + W_D2, MTOK, 1024, FF2, E); }
        STAMP(11);
        SYNC();
        if (PH(11)) { TSET for (int m = gw; m < MTOK; m += NGW) ln_row(xout + (size_t)m * DM, xout + (size_t)m * DM, P_(WS_XB) + (size_t)m * DM, KIN(17) + layer * DM, KIN(18) + layer * DM, lane); }
        STAMP(8);
        if (layer + 1 < NLAYER) { TSET if (PH(0)) { LOADIN(in) convert_layer(in, layer + 1, Wb, P_(WS_PB), (LAS float*)(lds + wave * 16384), gw, NGW, lane); } SYNC(); }
}

__global__ void __launch_bounds__(512, 2) mk_fwd(Args args) {
    extern __shared__ __attribute__((aligned(16))) unsigned char lds[];
    cg::grid_group grid = cg::this_grid();
    PG8_LAS unsigned char* ldsp = (PG8_LAS unsigned char*)lds;
    if (PROBE_SEL != 0u) { if (blockIdx.x == 0 && threadIdx.x == 0) { volatile LAS unsigned long long* tw_ = (volatile LAS unsigned long long*)(lds + 131072 + 1024); tw_[0] = __builtin_amdgcn_s_memrealtime(); tw_[1] = 0ull; } }
    if (threadIdx.x < 2) ((volatile LAS unsigned*)(lds + 131072 + 2048))[threadIdx.x] = 0u;
    __syncthreads();
    (void)xcd_barrier_post((unsigned*)KWS, (volatile LAS unsigned*)(lds + 131072 + 2048));
    { TSET
      if (PH(0)) { LOADIN(in) convert_layer(in, 0, Wb, P_(WS_PB), (LAS float*)(lds + wave * 16384), gw, NGW, lane); }
      float* cT = cosT; float* sT = sinT;
      for (int i = bid * 512 + tid; i < SEQ * 64; i += (int)gridDim.x * 512) { const int t = i >> 6, j = i & 63;
          const float inv = powf(10000.f, -(float)j * (1.f / 64.f)); const float ang = (float)t * inv; cT[i] = cosf(ang); sT[i] = sinf(ang); }
      const float* x = KIN(0); bf16_t* XB = P_(WS_XB);
      for (size_t i = (size_t)(bid * 512 + tid) * 8; i < (size_t)MTOK * DM; i += (size_t)gridDim.x * 512 * 8) { const f32x4 a = *(const f32x4*)(x + i), b = *(const f32x4*)(x + i + 4);
          u32x4 w; w.x = cvt_pk_bf16(a[0], a[1]); w.y = cvt_pk_bf16(a[2], a[3]); w.z = cvt_pk_bf16(b[0], b[1]); w.w = cvt_pk_bf16(b[2], b[3]); *(u32x4*)(XB + i) = w; } }
    grid.sync(); STAMP(15);

    layer_body<0>(lds, ldsp, grid);
    layer_body<1>(lds, ldsp, grid);
    layer_body<2>(lds, ldsp, grid);
    layer_body<3>(lds, ldsp, grid);
    if (PROBE_SEL != 0u) { if (blockIdx.x == 0 && threadIdx.x == 0) { volatile LAS unsigned long long* tw_ = (volatile LAS unsigned long long*)(lds + 131072 + 1024);
        const unsigned long long t0_ = __builtin_amdgcn_s_memrealtime(), want_ = (unsigned long long)PROBE_K * tw_[1]; while (__builtin_amdgcn_s_memrealtime() - t0_ < want_) __builtin_amdgcn_s_sleep(8); } }
}

extern "C" void kernel_launch(void* const* d_in, const int* in_sizes, int n_in, void* d_out, int out_size, void* d_ws, size_t ws_size, hipStream_t stream) {
    static int grid = 0;
    if (grid == 0) {
        if (n_in != 19 || out_size != MTOK * DM || ws_size < WS_END) { fprintf(stderr, "kernel_launch: unexpected shapes (n_in %d out %d ws %zu)\n", n_in, out_size, ws_size); grid = -1; return; }
        int dev = 0, cus = 0;
        if (hipGetDevice(&dev) != hipSuccess || hipDeviceGetAttribute(&cus, hipDeviceAttributeMultiprocessorCount, dev) != hipSuccess) { grid = -1; return; }
        if (hipFuncSetAttribute((const void*)mk_fwd, hipFuncAttributeMaxDynamicSharedMemorySize, LDS_BYTES) != hipSuccess) { fprintf(stderr, "kernel_launch: hipFuncSetAttribute failed\n"); grid = -1; return; }
        int per_cu = 0;
        if (hipOccupancyMaxActiveBlocksPerMultiprocessor(&per_cu, (const void*)mk_fwd, 512, LDS_BYTES) != hipSuccess || per_cu < 1) fprintf(stderr, "kernel_launch: occupancy query says %d\n", per_cu);
        (void)hipGetLastError();
        grid = cus;
    }
    if (grid < 0) return;
    if (hipMemsetAsync(d_ws, 0, 16384, stream) != hipSuccess) { fprintf(stderr, "kernel_launch: hipMemsetAsync failed\n"); return; }
    Args a{};
    for (int i = 0; i < 19; ++i) a.in[i] = (const float*)d_in[i];
    a.out = (float*)d_out; a.ws = (unsigned char*)d_ws;
    void* kargs[] = {&a};
    hipError_t e = hipLaunchCooperativeKernel((const void*)mk_fwd, dim3(grid), dim3(512), kargs, LDS_BYTES, stream);
    if (e != hipSuccess) fprintf(stderr, "kernel_launch: cooperative launch failed: %s (grid %d)\n", hipGetErrorString(e), grid);
}
```

```cpp
#include <hip/hip_runtime.h>
#include <hip/hip_cooperative_groups.h>
#include <cstdio>
#include <cstdint>
namespace cg = cooperative_groups;
namespace pg8 {
#define PG8_LAS __attribute__((address_space(3)))
typedef unsigned short bf16_t;
typedef short bf16x8 __attribute__((ext_vector_type(8)));
typedef float f32x4 __attribute__((ext_vector_type(4)));
typedef unsigned u32x4 __attribute__((ext_vector_type(4)));
constexpr int BM = 256, BK = 64, HALF = 128, HTB = HALF * BK * 2  , STAGE_BYTES = 8 * HTB, NXCD = 8, WGM = 8;

__host__ __device__ __forceinline__ int lds_byte(int r, int c) { const int st = (r >> 4) * 2 + (c >> 5), rr = r & 15, cc = c & 31, ob = rr * 64 + cc * 2; return st * 1024 + (ob ^ (((ob >> 9) & 1) << 5)); }
__host__ __device__ __forceinline__ void stage_rc(int b, int& R, int& C) { const int st = b / 1024, sb = b % 1024, swz = sb ^ (((sb >> 9) & 1) << 5); R = (st >> 1) * 16 + swz / 64; C = (st & 1) * 32 + (swz % 64) / 2; }
__host__ __device__ __forceinline__ int perm32(int rho) { const int n = rho >> 4, i = rho & 15; return 8 * (i >> 2) + 4 * n + (i & 3); }

struct Unit { int pm, pn; };
struct Gemm { const bf16_t* A; const bf16_t* Bt; int M, N, K; };

struct StaticOrder {
    int nM, nN, nwg, G, c;
    __host__ __device__ void init(int M, int N, int G_, int c_) { nM = M / BM; nN = N / BM; nwg = nM * nN; G = G_; c = c_; }
    __host__ __device__ bool next(int i, Unit& u) const {
        const long L = (long)i * G + c; if (L >= nwg) return false;
        int wgid = (int)L; { const int q = nwg / NXCD, r = nwg % NXCD, xcd = wgid % NXCD, off = wgid / NXCD; wgid = (xcd < r ? xcd * (q + 1) : r * (q + 1) + (xcd - r) * q) + off; }
        const int nig = WGM * nN, gid = wgid / nig, fm = gid * WGM, gsz = (nM - fm) < WGM ? (nM - fm) : WGM;
        u.pm = fm + ((wgid % nig) % gsz); u.pn = (wgid % nig) / gsz; return true;
    }
    __device__ __forceinline__ void a_ready(const Unit&) const {}
    __device__ __forceinline__ void done(const Unit&) const {}
};

__device__ __forceinline__ unsigned cvt_pk_bf16(float lo, float hi) { unsigned r; asm volatile("v_cvt_pk_bf16_f32 %0, %1, %2" : "=v"(r) : "v"(lo), "v"(hi)); return r; }
template <class Epi, class Sched, bool ALIGN_EPI = false, bool SP2 = false>
__device__ __forceinline__ void gemm_phase(PG8_LAS unsigned char* lds, const Gemm g, const Sched& S, const Epi& E) {
    int tid_raw_ = threadIdx.x; asm volatile("" : "+v"(tid_raw_)); const int tid = tid_raw_, wid = __builtin_amdgcn_readfirstlane(tid >> 6), lane = tid & 63, wr = wid >> 2, wc = wid & 3, fr = lane & 15, fq = lane >> 4;
    const int K = g.K, nt = K / BK;
    unsigned voffA[2], voffB[2];
#pragma unroll
    for (int i = 0; i < 2; ++i) { int R, C; stage_rc(tid * 16 + i * 8192, R, C); const int Rb = Epi::PERM ? ((R & ~31) + perm32(R & 31)) : R;
        voffA[i] = (unsigned)(R * K + C) * 2u; voffB[i] = (unsigned)(Rb * K + C) * 2u; }
    const size_t kstep = (size_t)(BK * 2);
    const size_t hstep = (size_t)HALF * K * 2;
    const size_t tstep = 2 * hstep;
    const unsigned ldsw = (unsigned)wid * 1024u;
    const int aoff = lds_byte(wr * 64 + fr, fq * 8), boff = lds_byte(wc * 32 + fr, fq * 8);
#define PG8_SA(b, h) (((b) * 2 + (h)) * HTB)
#define PG8_SB(b, h) ((4 + (b) * 2 + (h)) * HTB)
#define PG8_STAGE(bufoff, gbase, voff) do { _Pragma("unroll") for (int _i = 0; _i < 2; ++_i) \
        __builtin_amdgcn_global_load_lds((const unsigned*)((const char*)(gbase) + (voff)[_i]), (PG8_LAS unsigned*)(lds + (bufoff) + ldsw + _i * 8192), 16, 0, 0); } while (0)
#define PG8_LDA(dst, b, h) do { _Pragma("unroll") for (int m = 0; m < 4; ++m) _Pragma("unroll") for (int k = 0; k < 2; ++k) dst[m][k] = *(const PG8_LAS bf16x8*)(lds + PG8_SA(b, h) + aoff + m * 2048 + k * 1024); } while (0)
#define PG8_LDB(dst, b, h) do { _Pragma("unroll") for (int n = 0; n < 2; ++n) _Pragma("unroll") for (int k = 0; k < 2; ++k) dst[n][k] = *(const PG8_LAS bf16x8*)(lds + PG8_SB(b, h) + boff + n * 2048 + k * 1024); } while (0)
#define PG8_MMA(ai, bj, At, Bt) do { __builtin_amdgcn_s_setprio(1); _Pragma("unroll") for (int m = 0; m < 4; ++m) _Pragma("unroll") for (int n = 0; n < 2; ++n) _Pragma("unroll") for (int k = 0; k < 2; ++k) \
        acc[ai][bj][m][n] = __builtin_amdgcn_mfma_f32_16x16x32_bf16(Bt[n][k], At[m][k], acc[ai][bj][m][n], 0, 0, 0); __builtin_amdgcn_s_setprio(0); } while (0)
#define PG8_WAIT_V(n) asm volatile("s_waitcnt vmcnt(" #n ")" ::: "memory")
#define PG8_WAIT_L(n) asm volatile("s_waitcnt lgkmcnt(" #n ")" ::: "memory")
#define PG8_BAR __builtin_amdgcn_s_barrier()
#define PG8_SCHED __builtin_amdgcn_sched_barrier(0)
    Unit cur, nxt; int ui = 0;
    if (!S.next(0, cur)) return;
    f32x4 acc[2][2][4][2];
#pragma unroll
    for (int a = 0; a < 2; ++a)
#pragma unroll
        for (int b = 0; b < 2; ++b)
#pragma unroll
            for (int m = 0; m < 4; ++m)
#pragma unroll
                for (int n = 0; n < 2; ++n) acc[a][b][m][n] = (f32x4){0.f, 0.f, 0.f, 0.f};
    bf16x8 At[4][2], B0[2][2], B1[2][2];
    const char* cA = (const char*)g.A + (size_t)cur.pm * tstep; const char* cB = (const char*)g.Bt + (size_t)cur.pn * tstep;
    S.a_ready(cur);
    if constexpr (SP2) {
        PG8_STAGE(PG8_SB(0, 0), cB, voffB); PG8_STAGE(PG8_SB(0, 1), cB + hstep, voffB); PG8_STAGE(PG8_SA(0, 0), cA, voffA); PG8_STAGE(PG8_SA(0, 1), cA + hstep, voffA);
        if (wr == 1) PG8_BAR;
        PG8_WAIT_V(2); PG8_BAR;
        PG8_STAGE(PG8_SB(1, 0), cB + kstep, voffB); PG8_STAGE(PG8_SA(1, 0), cA + kstep, voffA); PG8_STAGE(PG8_SB(1, 1), cB + hstep + kstep, voffB);
        PG8_WAIT_V(6); PG8_BAR;
    } else {
        PG8_STAGE(PG8_SB(0, 0), cB, voffB); PG8_STAGE(PG8_SA(0, 0), cA, voffA); PG8_STAGE(PG8_SB(0, 1), cB + hstep, voffB); PG8_STAGE(PG8_SA(0, 1), cA + hstep, voffA);
        if (wr == 1) PG8_BAR;
        PG8_WAIT_V(4); PG8_BAR;
        PG8_STAGE(PG8_SB(1, 0), cB + kstep, voffB); PG8_STAGE(PG8_SA(1, 0), cA + kstep, voffA); PG8_STAGE(PG8_SB(1, 1), cB + hstep + kstep, voffB);
        PG8_WAIT_V(6); PG8_BAR;
    }
    for (;;) {
        const bool has_next = S.next(ui + 1, nxt);
        const char* nA = has_next ? (const char*)g.A + (size_t)nxt.pm * tstep : cA; const char* nB = has_next ? (const char*)g.Bt + (size_t)nxt.pn * tstep : cB;
        for (int t = 0; t < nt; t += 2) {
            const bool last = (t == nt - 2);
            const char* a1 = cA + (size_t)(t + 1) * kstep;
            const char* a2 = last ? nA : cA + (size_t)(t + 2) * kstep; const char* b2 = last ? nB : cB + (size_t)(t + 2) * kstep;
            const char* a3 = a2 + kstep; const char* b3 = b2 + kstep;
            if (last && has_next) S.a_ready(nxt);
            if constexpr (SP2) {
            PG8_LDB(B0, 0, 0); PG8_LDB(B1, 0, 1); PG8_SCHED; PG8_LDA(At, 0, 0); PG8_STAGE(PG8_SA(1, 1), a1 + hstep, voffA);
            PG8_WAIT_V(8); PG8_WAIT_L(0); PG8_BAR; PG8_MMA(0, 0, At, B0); PG8_MMA(0, 1, At, B1); PG8_BAR; PG8_SCHED;
            PG8_LDA(At, 0, 1); PG8_STAGE(PG8_SB(0, 0), b2, voffB); PG8_STAGE(PG8_SB(0, 1), b2 + hstep, voffB); PG8_STAGE(PG8_SA(0, 0), a2, voffA);
            PG8_WAIT_V(8); PG8_WAIT_L(0); PG8_BAR; PG8_MMA(1, 0, At, B0); PG8_MMA(1, 1, At, B1); PG8_BAR; PG8_SCHED;
            PG8_LDB(B0, 1, 0); PG8_LDB(B1, 1, 1); PG8_SCHED; PG8_LDA(At, 1, 0); PG8_STAGE(PG8_SA(0, 1), a2 + hstep, voffA);
            PG8_WAIT_V(8); PG8_WAIT_L(0); PG8_BAR; PG8_MMA(0, 0, At, B0); PG8_MMA(0, 1, At, B1); PG8_BAR; PG8_SCHED;
            PG8_LDA(At, 1, 1); PG8_STAGE(PG8_SB(1, 0), b3, voffB); PG8_STAGE(PG8_SB(1, 1), b3 + hstep, voffB); PG8_STAGE(PG8_SA(1, 0), a3, voffA);
            PG8_WAIT_V(8); PG8_WAIT_L(0); PG8_BAR; PG8_MMA(1, 0, At, B0); PG8_MMA(1, 1, At, B1); PG8_BAR; PG8_SCHED;
            } else {
            PG8_LDB(B0, 0, 0); PG8_SCHED; PG8_LDA(At, 0, 0); PG8_STAGE(PG8_SA(1, 1), a1 + hstep, voffA);
            PG8_WAIT_L(8); PG8_BAR; PG8_WAIT_L(0); PG8_MMA(0, 0, At, B0); PG8_BAR; PG8_SCHED;
            PG8_LDB(B1, 0, 1); PG8_STAGE(PG8_SB(0, 0), b2, voffB);
            PG8_BAR; PG8_WAIT_L(0); PG8_MMA(0, 1, At, B1); PG8_BAR;
            PG8_LDA(At, 0, 1); PG8_STAGE(PG8_SA(0, 0), a2, voffA);
            PG8_BAR; PG8_WAIT_L(0); PG8_MMA(1, 0, At, B0); PG8_BAR; PG8_SCHED;
            PG8_STAGE(PG8_SB(0, 1), b2 + hstep, voffB);
            PG8_WAIT_V(6); PG8_BAR; PG8_MMA(1, 1, At, B1); PG8_BAR;
            PG8_LDB(B0, 1, 0); PG8_SCHED; PG8_LDA(At, 1, 0); PG8_STAGE(PG8_SA(0, 1), a2 + hstep, voffA);
            PG8_WAIT_L(8); PG8_BAR; PG8_WAIT_L(0); PG8_MMA(0, 0, At, B0); PG8_BAR; PG8_SCHED;
            PG8_LDB(B1, 1, 1); PG8_STAGE(PG8_SB(1, 0), b3, voffB);
            PG8_BAR; PG8_WAIT_L(0); PG8_MMA(0, 1, At, B1); PG8_BAR;
            PG8_LDA(At, 1, 1); PG8_STAGE(PG8_SA(1, 0), a3, voffA);
            PG8_BAR; PG8_WAIT_L(0); PG8_MMA(1, 0, At, B0); PG8_BAR; PG8_SCHED;
            PG8_STAGE(PG8_SB(1, 1), b3 + hstep, voffB);
            PG8_WAIT_V(6); PG8_BAR; PG8_MMA(1, 1, At, B1); PG8_BAR;
            }
        }
        if constexpr (ALIGN_EPI) { if (wr == 0) PG8_BAR; }
        if constexpr (!Epi::AFTER_DRAIN) { E(acc, cur, wr, wc, fr, fq); S.done(cur); }
        if (!has_next) break;
#pragma unroll
        for (int a = 0; a < 2; ++a)
#pragma unroll
            for (int b = 0; b < 2; ++b)
#pragma unroll
                for (int m = 0; m < 4; ++m)
#pragma unroll
                    for (int n = 0; n < 2; ++n) acc[a][b][m][n] = (f32x4){0.f, 0.f, 0.f, 0.f};
        cur = nxt; cA = nA; cB = nB; ++ui;
        if constexpr (ALIGN_EPI) { if (wr == 1) PG8_BAR; }
    }
    PG8_WAIT_V(0);
    if constexpr (!ALIGN_EPI) { if (wr == 0) PG8_BAR; }
    PG8_BAR;
    if constexpr (Epi::AFTER_DRAIN) { E.fused(acc, cur, wr, wc, fr, fq, lds, wid, lane); S.done(cur); }
#undef PG8_SA
#undef PG8_SB
#undef PG8_STAGE
#undef PG8_LDA
#undef PG8_LDB
#undef PG8_MMA
#undef PG8_WAIT_V
#undef PG8_WAIT_L
#undef PG8_BAR
#undef PG8_SCHED
}
}

using namespace pg8;
#define LAS __attribute__((address_space(3)))
typedef unsigned u32x2 __attribute__((ext_vector_type(2)));
constexpr int MTOK = 32768, DM = 1024, SEQ = 8192, NLAYER = 4;
constexpr float ALPHA = 1.681792830507429f;
constexpr float LN_EPS = 1e-5f, GN_EPS = 1e-6f;
constexpr size_t MiB = 1u << 20;
constexpr size_t WS_COS = 1 * MiB, WS_SIN = 3 * MiB, WS_W = 6 * MiB, WS_XB = 44 * MiB, WS_QNA = 108 * MiB, WS_KNA = 140 * MiB, WS_VTNA = 172 * MiB,
                 WS_KT = 204 * MiB, WS_QR = 268 * MiB, WS_KR = 300 * MiB, WS_VTR = 332 * MiB, WS_GR = 396 * MiB, WS_ST = 460 * MiB, WS_PB = 524 * MiB,
                 WS_GA = 140 * MiB, WS_GB = 204 * MiB, WS_MRG = 268 * MiB, WS_SG = 108 * MiB, WS_H = 172 * MiB, WS_U = 364 * MiB, WS_END = 540 * MiB;
constexpr size_t W_IN = 0, W_A = W_IN + (size_t)6656 * 1024, W_B = W_A + (size_t)1024 * 512, W_O = W_B + (size_t)1024 * 1024, W_UP = W_O + (size_t)1024 * 1024,
                 W_D1 = W_UP + (size_t)5632 * 1024, W_D2 = W_D1 + (size_t)1024 * 1536, W_PG = W_D2 + (size_t)1024 * 1280, W_PP = W_PG + (size_t)1024 * 1024, W_TOTAL = W_PP + (size_t)1024 * 256;
static_assert(W_TOTAL * 2 <= 38 * MiB, "weights fit");
constexpr int FF1 = 1536, FF2 = 1280;

__device__ __forceinline__ float bflo(unsigned w) { return __uint_as_float(w << 16); }
__device__ __forceinline__ float bfhi(unsigned w) { return __uint_as_float(w & 0xffff0000u); }
__device__ __forceinline__ float sigm(float x) { return 1.f / (1.f + __expf(-x)); }
__device__ __forceinline__ float gelu_tanh(float x) { const float y = 0.7978845608028654f * (x + 0.044715f * x * x * x); const float t = 1.f - 2.f / (__expf(2.f * y) + 1.f); return 0.5f * x * (1.f + t); }
__device__ __forceinline__ bf16x8 mk8(unsigned a, unsigned b, unsigned c, unsigned d) { u32x4 w = {a, b, c, d}; return __builtin_bit_cast(bf16x8, w); }
__device__ __forceinline__ bf16x8 scale8(bf16x8 v, float s) { u32x4 w = __builtin_bit_cast(u32x4, v);
    return mk8(cvt_pk_bf16(bflo(w.x) * s, bfhi(w.x) * s), cvt_pk_bf16(bflo(w.y) * s, bfhi(w.y) * s), cvt_pk_bf16(bflo(w.z) * s, bfhi(w.z) * s), cvt_pk_bf16(bflo(w.w) * s, bfhi(w.w) * s)); }
#define MFMA16(a, b, c) __builtin_amdgcn_mfma_f32_16x16x32_bf16((a), (b), (c), 0, 0, 0)

template <int ACT> struct EpiBf {
    static constexpr bool PERM = true, AFTER_DRAIN = false;
    bf16_t* base0; bf16_t* base1; int nsplit; int ld;
    __device__ __forceinline__ void operator()(const f32x4 (&acc)[2][2][4][2], const Unit& u, int wr, int wc, int fr, int fq) const {
        bf16_t* base = (u.pn < nsplit) ? base0 + u.pn * 256 : base1 + (u.pn - nsplit) * 256;
        const int row0 = u.pm * 256 + wr * 64 + fr, col0 = wc * 32 + 8 * fq;
#pragma unroll
        for (int ai = 0; ai < 2; ++ai)
#pragma unroll
            for (int m = 0; m < 4; ++m) { bf16_t* rowp = base + (size_t)(row0 + ai * HALF + m * 16) * ld + col0;
#pragma unroll
                for (int bj = 0; bj < 2; ++bj) { f32x4 v0 = acc[ai][bj][m][0], v1 = acc[ai][bj][m][1];
                    if (ACT == 2) { v0 = (f32x4){sigm(v0[0]), sigm(v0[1]), sigm(v0[2]), sigm(v0[3])}; v1 = (f32x4){sigm(v1[0]), sigm(v1[1]), sigm(v1[2]), sigm(v1[3])}; }
                    u32x4 w; w.x = cvt_pk_bf16(v0[0], v0[1]); w.y = cvt_pk_bf16(v0[2], v0[3]); w.z = cvt_pk_bf16(v1[0], v1[1]); w.w = cvt_pk_bf16(v1[2], v1[3]);
                    *(u32x4*)(rowp + bj * HALF) = w; } }
    }
};
struct EpiVT {
    static constexpr bool PERM = true, AFTER_DRAIN = false;
    bf16_t* vtna; bf16_t* vtr;
    __device__ __forceinline__ void operator()(const f32x4 (&acc)[2][2][4][2], const Unit& u, int wr, int wc, int fr, int fq) const {
        bf16_t* base = (u.pm < 2) ? vtna + (size_t)(u.pm * 256) * MTOK : vtr + (size_t)((u.pm - 2) * 256) * MTOK;
        const int row0 = wr * 64 + fr, col0 = u.pn * 256 + wc * 32 + 8 * fq;
#pragma unroll
        for (int ai = 0; ai < 2; ++ai)
#pragma unroll
            for (int m = 0; m < 4; ++m) { bf16_t* rowp = base + (size_t)(row0 + ai * HALF + m * 16) * MTOK + col0;
#pragma unroll
                for (int bj = 0; bj < 2; ++bj) { const f32x4 v0 = acc[ai][bj][m][0], v1 = acc[ai][bj][m][1];
                    u32x4 w; w.x = cvt_pk_bf16(v0[0], v0[1]); w.y = cvt_pk_bf16(v0[2], v0[3]); w.z = cvt_pk_bf16(v1[0], v1[1]); w.w = cvt_pk_bf16(v1[2], v1[3]);
                    *(u32x4*)(rowp + bj * HALF) = w; } }
    }
};
struct EpiProj {
    static constexpr bool PERM = true, AFTER_DRAIN = false;
    bf16_t *qna, *kna, *qr, *kr, *kt, *gr; const float* cosT; const float* sinT;
    __device__ __forceinline__ void operator()(const f32x4 (&acc)[2][2][4][2], const Unit& u, int wr, int wc, int fr, int fq) const {
        const int pn = u.pn, row0 = u.pm * 256 + wr * 64 + fr;
        if (pn < 4 || pn >= 8) {
            bf16_t* base; int ld; float sc = 1.f;
            if (pn < 2) { base = qna + pn * 256; ld = 512; sc = 0.125f; } else if (pn < 4) { base = kna + (pn - 2) * 256; ld = 512; } else { base = gr + (pn - 8) * 256; ld = 1024; }
            const int col0 = wc * 32 + 8 * fq;
#pragma unroll
            for (int ai = 0; ai < 2; ++ai)
#pragma unroll
                for (int m = 0; m < 4; ++m) { bf16_t* rowp = base + (size_t)(row0 + ai * HALF + m * 16) * ld + col0;
#pragma unroll
                    for (int bj = 0; bj < 2; ++bj) { const f32x4 v0 = acc[ai][bj][m][0] * sc, v1 = acc[ai][bj][m][1] * sc;
                        u32x4 w; w.x = cvt_pk_bf16(v0[0], v0[1]); w.y = cvt_pk_bf16(v0[2], v0[3]); w.z = cvt_pk_bf16(v1[0], v1[1]); w.w = cvt_pk_bf16(v1[2], v1[3]);
                        *(u32x4*)(rowp + bj * HALF) = w; } }
        } else {
            const bool isk = pn >= 6; bf16_t* base = isk ? kr : qr; const int hb = (isk ? pn - 6 : pn - 4) * 2;
            const float sc = isk ? 0.08838834764831845f : 1.f;
            const int i4 = 4 * (4 * wc + fq);
#pragma unroll
            for (int ai = 0; ai < 2; ++ai)
#pragma unroll
                for (int m = 0; m < 4; ++m) { const int row = row0 + ai * HALF + m * 16, t = row & (SEQ - 1);
                    const f32x4 c = *(const f32x4*)(cosT + t * 64 + i4), s = *(const f32x4*)(sinT + t * 64 + i4);
#pragma unroll
                    for (int bj = 0; bj < 2; ++bj) { const int head = hb + bj; const f32x4 x1 = acc[ai][bj][m][0], x2 = acc[ai][bj][m][1];
                        const f32x4 o1 = (x1 * c - x2 * s) * sc, o2 = (x2 * c + x1 * s) * sc;
                        u32x2 w1, w2; w1.x = cvt_pk_bf16(o1[0], o1[1]); w1.y = cvt_pk_bf16(o1[2], o1[3]); w2.x = cvt_pk_bf16(o2[0], o2[1]); w2.y = cvt_pk_bf16(o2[2], o2[3]);
                        bf16_t* p = base + (size_t)row * 512 + head * 128 + i4;
                        *(u32x2*)p = w1; *(u32x2*)(p + 64) = w2;
                        if (isk) { bf16_t* q = kt + (size_t)(head * 128 + i4) * MTOK + row;
                            q[0] = (bf16_t)(w1.x & 0xffffu); q[(size_t)MTOK] = (bf16_t)(w1.x >> 16); q[(size_t)2 * MTOK] = (bf16_t)(w1.y & 0xffffu); q[(size_t)3 * MTOK] = (bf16_t)(w1.y >> 16);
                            bf16_t* q2 = q + (size_t)64 * MTOK;
                            q2[0] = (bf16_t)(w2.x & 0xffffu); q2[(size_t)MTOK] = (bf16_t)(w2.x >> 16); q2[(size_t)2 * MTOK] = (bf16_t)(w2.y & 0xffffu); q2[(size_t)3 * MTOK] = (bf16_t)(w2.y >> 16); } } }
        }
    }
};
template <int MODE> struct EpiMerge {
    static constexpr bool PERM = true, AFTER_DRAIN = false;
    bf16_t* mrg; const bf16_t* gate;
    __device__ __forceinline__ void operator()(const f32x4 (&acc)[2][2][4][2], const Unit& u, int wr, int wc, int fr, int fq) const {
        const int row0 = u.pm * 256 + wr * 64 + fr, col0 = u.pn * 256 + wc * 32 + 8 * fq;
#pragma unroll
        for (int ai = 0; ai < 2; ++ai)
#pragma unroll
            for (int m = 0; m < 4; ++m) { const size_t off = (size_t)(row0 + ai * HALF + m * 16) * 1024 + col0;
#pragma unroll
                for (int bj = 0; bj < 2; ++bj) { const f32x4 v0 = acc[ai][bj][m][0], v1 = acc[ai][bj][m][1];
                    const u32x4 g = *(const u32x4*)(gate + off + bj * HALF);
                    float r0 = bflo(g.x) * v0[0], r1 = bfhi(g.x) * v0[1], r2 = bflo(g.y) * v0[2], r3 = bfhi(g.y) * v0[3], r4 = bflo(g.z) * v1[0], r5 = bfhi(g.z) * v1[1], r6 = bflo(g.w) * v1[2], r7 = bfhi(g.w) * v1[3];
                    if (MODE == 1) { const u32x4 p = *(const u32x4*)(mrg + off + bj * HALF);
                        r0 += bflo(p.x); r1 += bfhi(p.x); r2 += bflo(p.y); r3 += bfhi(p.y); r4 += bflo(p.z); r5 += bfhi(p.z); r6 += bflo(p.w); r7 += bfhi(p.w); }
                    u32x4 w; w.x = cvt_pk_bf16(r0, r1); w.y = cvt_pk_bf16(r2, r3); w.z = cvt_pk_bf16(r4, r5); w.w = cvt_pk_bf16(r6, r7);
                    *(u32x4*)(mrg + off + bj * HALF) = w; } }
    }
};
template <int MODE> struct EpiF32 {
    static constexpr bool PERM = false, AFTER_DRAIN = false;
    float* out; const float* res; const bf16_t* sg;
    __device__ __forceinline__ void operator()(const f32x4 (&acc)[2][2][4][2], const Unit& u, int wr, int wc, int fr, int fq) const {
        const int row0 = u.pm * 256 + wr * 64 + fr, col0 = u.pn * 256 + wc * 32 + 4 * fq;
#pragma unroll
        for (int ai = 0; ai < 2; ++ai)
#pragma unroll
            for (int m = 0; m < 4; ++m) { const size_t off = (size_t)(row0 + ai * HALF + m * 16) * 1024 + col0;
#pragma unroll
                for (int bj = 0; bj < 2; ++bj)
#pragma unroll
                    for (int n = 0; n < 2; ++n) { const size_t o = off + bj * HALF + n * 16; const f32x4 a = acc[ai][bj][m][n]; f32x4 r;
                        if (MODE == 0) { r = *(const f32x4*)(res + o) * ALPHA + a; }
                        else if (MODE == 1) { const u32x2 g = *(const u32x2*)(sg + o); const f32x4 gv = {bflo(g.x), bfhi(g.x), bflo(g.y), bfhi(g.y)}; r = *(const f32x4*)(out + o) * ALPHA + gv * a; }
                        else { r = *(const f32x4*)(out + o) + a; }
                        *(f32x4*)(out + o) = r; } }
    }
};

__device__ __forceinline__ float wave_sum(float v) {
#pragma unroll
    for (int o = 1; o < 64; o <<= 1) v += __shfl_xor(v, o);
    return v;
}
__device__ __forceinline__ int rotp(int x) { const int head = x >> 7, d = x & 127, i = (d & 63) >> 2, e = d & 3; return head * 128 + 8 * i + ((d >> 6) << 2) + e; }
__device__ __forceinline__ int map_win(int n) {
    if (n < 1024) return n;
    if (n < 1536) return 3072 + (n - 1024);
    if (n < 2048) return 1024 + rotp(n - 1536);
    if (n < 2560) return 1536 + rotp(n - 2048);
    if (n < 3584) return 3584 + (n - 2560);
    if (n < 4608) return 2048 + (n - 3584);
    return n;
}
__device__ __forceinline__ int map_wup(int n) {
    const bool a = n < 2816; const int j = a ? n : n - 2816;
    if (j < FF1) return (a ? 0 : FF1) + j;
    return 2 * FF1 + (a ? 0 : FF2) + (j - FF1);
}
template <int MAP> __device__ __forceinline__ void transpose_item(const float* W, int N, int k0, int n0, bf16_t* dst, int dstK, int kbase, LAS float* scr, int lane) {
#pragma unroll 8
    for (int i = 0; i < 32; ++i) { const int kk = 2 * i + (lane >> 5); scr[kk * 33 + (lane & 31)] = W[(size_t)(k0 + kk) * N + n0 + (lane & 31)]; }
    asm volatile("s_waitcnt lgkmcnt(0)" ::: "memory");
    const int c = lane & 7;
#pragma unroll
    for (int j = 0; j < 4; ++j) { const int n = (lane >> 3) + 8 * j; const LAS float* s = scr + (8 * c) * 33 + n;
        u32x4 o; o.x = cvt_pk_bf16(s[0 * 33], s[1 * 33]); o.y = cvt_pk_bf16(s[2 * 33], s[3 * 33]); o.z = cvt_pk_bf16(s[4 * 33], s[5 * 33]); o.w = cvt_pk_bf16(s[6 * 33], s[7 * 33]);
        const int sn = n0 + n; const int dr = (MAP == 1) ? map_win(sn) : (MAP == 2) ? map_wup(sn) : sn;
        *(u32x4*)(dst + (size_t)dr * dstK + (k0 - kbase) + 8 * c) = o; }
    asm volatile("s_waitcnt lgkmcnt(0)" ::: "memory");
}
struct In { const float* p[19]; };
__device__ __forceinline__ void convert_layer(const In& in, int layer, bf16_t* Wb, bf16_t* PB, LAS float* scr, int gw, int NGW, int lane) {
    const float* w_in = in.p[2] + (size_t)layer * 1024 * 6656; const float* w_a = in.p[6] + (size_t)layer * 512 * 1024; const float* w_b = in.p[7] + (size_t)layer * 1024 * 1024;
    const float* w_o = in.p[8] + (size_t)layer * 1024 * 1024; const float* w_up = in.p[11] + (size_t)layer * 1024 * 5632; const float* w_dn = in.p[14] + (size_t)layer * 2816 * 1024;
    const float* w_pg = in.p[15] + (size_t)layer * 1024 * 1024; const float* w_pp = in.p[16] + (size_t)layer * 256 * 1024;
    constexpr int I_IN = 16 * 208, I_A = 8 * 32, I_B = 16 * 32, I_O = 16 * 32, I_UP = 16 * 176, I_D1 = 24 * 32, I_D2 = 20 * 32, I_PG = 16 * 32, I_PP = 4 * 32;
    constexpr int NIT = I_IN + I_A + I_B + I_O + I_UP + I_D1 + I_D2 + I_PG + I_PP;
    for (int it = gw; it < NIT; it += NGW) {
        int r = it;
        if (r < I_IN) { transpose_item<1>(w_in, 6656, 64 * (r / 208), 32 * (r % 208), Wb + W_IN, 1024, 0, scr, lane); continue; } r -= I_IN;
        if (r < I_A) { transpose_item<0>(w_a, 1024, 64 * (r / 32), 32 * (r % 32), Wb + W_A, 512, 0, scr, lane); continue; } r -= I_A;
        if (r < I_B) { transpose_item<0>(w_b, 1024, 64 * (r / 32), 32 * (r % 32), Wb + W_B, 1024, 0, scr, lane); continue; } r -= I_B;
        if (r < I_O) { transpose_item<0>(w_o, 1024, 64 * (r / 32), 32 * (r % 32), Wb + W_O, 1024, 0, scr, lane); continue; } r -= I_O;
        if (r < I_UP) { transpose_item<2>(w_up, 5632, 64 * (r / 176), 32 * (r % 176), Wb + W_UP, 1024, 0, scr, lane); continue; } r -= I_UP;
        if (r < I_D1) { transpose_item<0>(w_dn, 1024, 64 * (r / 32), 32 * (r % 32), Wb + W_D1, FF1, 0, scr, lane); continue; } r -= I_D1;
        if (r < I_D2) { transpose_item<0>(w_dn, 1024, FF1 + 64 * (r / 32), 32 * (r % 32), Wb + W_D2, FF2, FF1, scr, lane); continue; } r -= I_D2;
        if (r < I_PG) { transpose_item<0>(w_pg, 1024, 64 * (r / 32), 32 * (r % 32), Wb + W_PG, 1024, 0, scr, lane); continue; } r -= I_PG;
        transpose_item<0>(w_pp, 1024, 64 * (r / 32), 32 * (r % 32), Wb + W_PP, 256, 0, scr, lane);
    }
    const float* ps = in.p[1] + (size_t)layer * MTOK * 256;
    for (int i = gw; i < MTOK * 256 / 512; i += NGW) { const size_t e = (size_t)i * 512 + lane * 8; const f32x4 a = *(const f32x4*)(ps + e), b = *(const f32x4*)(ps + e + 4);
        u32x4 w; w.x = cvt_pk_bf16(a[0], a[1]); w.y = cvt_pk_bf16(a[2], a[3]); w.z = cvt_pk_bf16(b[0], b[1]); w.w = cvt_pk_bf16(b[2], b[3]); *(u32x4*)(PB + e) = w; }
}
__device__ __forceinline__ void ln_row(const float* src, float* dst, bf16_t* xb, const float* g, const float* b, int lane) {
    const f32x4* xr = (const f32x4*)src + lane; f32x4 v[4]; float s = 0.f;
#pragma unroll
    for (int j = 0; j < 4; ++j) { v[j] = xr[64 * j]; s += (v[j][0] + v[j][1]) + (v[j][2] + v[j][3]); }
    const float mean = wave_sum(s) * (1.f / DM); float s2 = 0.f;
#pragma unroll
    for (int j = 0; j < 4; ++j) { v[j] = v[j] - mean; s2 += (v[j][0] * v[j][0] + v[j][1] * v[j][1]) + (v[j][2] * v[j][2] + v[j][3] * v[j][3]); }
    const float rstd = 1.f / sqrtf(wave_sum(s2) * (1.f / DM) + LN_EPS);
#pragma unroll
    for (int j = 0; j < 4; ++j) { const f32x4 gg = ((const f32x4*)g)[lane + 64 * j], bb = ((const f32x4*)b)[lane + 64 * j]; const f32x4 o = v[j] * rstd * gg + bb;
        ((f32x4*)dst)[lane + 64 * j] = o; u32x2 w; w.x = cvt_pk_bf16(o[0], o[1]); w.y = cvt_pk_bf16(o[2], o[3]); ((u32x2*)xb)[lane + 64 * j] = w; }
}

__device__ __forceinline__ void na_phase(bf16_t* QNA, const bf16_t* KNA, const bf16_t* VT, const float* rpb, LAS float* ldsf, int tid, int wave, int lane, int bid) {
    for (int i = tid; i < 8 * 465; i += 512) ldsf[i] = rpb[i];
    __syncthreads();
    const int fr = lane & 15, fq = lane >> 4;
    for (int unit = bid * 8 + wave; unit < 16384; unit += gridDim.x * 8) {
        const int j = unit & 3, h = (unit >> 2) & 7, r = (unit >> 5) & 127, b = unit >> 12;
        const int tq = b * SEQ + r * 64 + 16 * j;
        const int rs = min(max(r - 4, 0), 120), c0 = min(max(16 * j - 8, 0), 32);
        const int qcol = 16 * j + fr, cs = min(max(qcol - 8, 0), 48);
        bf16_t* qp = QNA + (size_t)(tq + fr) * 512 + h * 64;
        const bf16x8 qf0 = *(const bf16x8*)(qp + 8 * fq), qf1 = *(const bf16x8*)(qp + 32 + 8 * fq);
        f32x4 s[16]; float mx = -INFINITY;
#pragma unroll
        for (int a = 0; a < 16; ++a) { const int kr = a >> 1;
            const int kcl = 8 * (fr >> 2) + 4 * (a & 1) + (fr & 3);
            const bf16_t* kp = KNA + (size_t)(b * SEQ + (rs + kr) * 64 + c0 + kcl) * 512 + h * 64 + 8 * fq;
            const bf16x8 kf0 = *(const bf16x8*)kp, kf1 = *(const bf16x8*)(kp + 32);
            f32x4 acc = {0.f, 0.f, 0.f, 0.f}; acc = MFMA16(kf0, qf0, acc); acc = MFMA16(kf1, qf1, acc);
            const LAS float* bp = ldsf + h * 465 + (rs + kr - r + 7) * 31;
#pragma unroll
            for (int v = 0; v < 4; ++v) { const int kcol = c0 + 8 * fq + 4 * (a & 1) + v; const bool valid = (kcol >= cs) && (kcol < cs + 16);
                const int bi = min(max(kcol - qcol + 15, 0), 30);
                const float sv = valid ? acc[v] + bp[bi] : -INFINITY; s[a][v] = sv; mx = fmaxf(mx, sv); } }
        mx = fmaxf(mx, __shfl_xor(mx, 16)); mx = fmaxf(mx, __shfl_xor(mx, 32));
        float l = 0.f;
#pragma unroll
        for (int a = 0; a < 16; ++a)
#pragma unroll
            for (int v = 0; v < 4; ++v) { const float p = __expf(s[a][v] - mx); s[a][v] = p; l += p; }
        l += __shfl_xor(l, 16); l += __shfl_xor(l, 32);
        const float rl = 1.f / l;
        f32x4 o[4];
#pragma unroll
        for (int dt = 0; dt < 4; ++dt) o[dt] = (f32x4){0.f, 0.f, 0.f, 0.f};
#pragma unroll
        for (int ks = 0; ks < 8; ++ks) {
            const bf16x8 pf = mk8(cvt_pk_bf16(s[2 * ks][0], s[2 * ks][1]), cvt_pk_bf16(s[2 * ks][2], s[2 * ks][3]), cvt_pk_bf16(s[2 * ks + 1][0], s[2 * ks + 1][1]), cvt_pk_bf16(s[2 * ks + 1][2], s[2 * ks + 1][3]));
            const size_t tk = (size_t)b * SEQ + (rs + ks) * 64 + c0 + 8 * fq;
#pragma unroll
            for (int dt = 0; dt < 4; ++dt) { const bf16x8 vf = *(const bf16x8*)(VT + (size_t)(h * 64 + 16 * dt + fr) * MTOK + tk);
                o[dt] = MFMA16(vf, pf, o[dt]); } }
#pragma unroll
        for (int dt = 0; dt < 4; ++dt) { u32x2 w; w.x = cvt_pk_bf16(o[dt][0] * rl, o[dt][1] * rl); w.y = cvt_pk_bf16(o[dt][2] * rl, o[dt][3] * rl);
            *(u32x2*)(qp + 16 * dt + 4 * fq) = w; }
    }
    __syncthreads();
}

__device__ __forceinline__ void ret_kv_phase(const bf16_t* KT, const bf16_t* VT, bf16_t* ST, const float* dec_f, const float* dec_b, int wave, int lane, int bid) {
    const int fr = lane & 15, fq = lane >> 4;
    for (int unit = bid; unit < 512; unit += gridDim.x) {
        const int c = unit & 31, bh = unit >> 5, h = bh & 3, b = bh >> 2;
        const size_t tok0 = (size_t)b * SEQ + c * 256;
        const float lgf = log2f(1.f / (1.f + expf(-dec_f[h]))), lgb = log2f(1.f / (1.f + expf(-dec_b[h])));
        f32x4 af[16], ab[16];
#pragma unroll
        for (int dt = 0; dt < 16; ++dt) { af[dt] = (f32x4){0.f, 0.f, 0.f, 0.f}; ab[dt] = (f32x4){0.f, 0.f, 0.f, 0.f}; }
        const bf16_t* kp = KT + (size_t)(h * 128 + 16 * wave + fr) * MTOK + tok0 + 8 * fq;
        const bf16_t* vp = VT + (size_t)(h * 256 + fr) * MTOK + tok0 + 8 * fq;
#pragma unroll 1
        for (int s = 0; s < 8; ++s) {
            const u32x4 kw = *(const u32x4*)(kp + 32 * s);
            const int j0 = 32 * s + 8 * fq;
            float zf[8], zb[8];
#pragma unroll
            for (int e = 0; e < 8; ++e) { zf[e] = exp2f(lgf * (float)(255 - j0 - e)); zb[e] = exp2f(lgb * (float)(j0 + e)); }
            const bf16x8 kf = mk8(cvt_pk_bf16(bflo(kw.x) * zf[0], bfhi(kw.x) * zf[1]), cvt_pk_bf16(bflo(kw.y) * zf[2], bfhi(kw.y) * zf[3]), cvt_pk_bf16(bflo(kw.z) * zf[4], bfhi(kw.z) * zf[5]), cvt_pk_bf16(bflo(kw.w) * zf[6], bfhi(kw.w) * zf[7]));
            const bf16x8 kb = mk8(cvt_pk_bf16(bflo(kw.x) * zb[0], bfhi(kw.x) * zb[1]), cvt_pk_bf16(bflo(kw.y) * zb[2], bfhi(kw.y) * zb[3]), cvt_pk_bf16(bflo(kw.z) * zb[4], bfhi(kw.z) * zb[5]), cvt_pk_bf16(bflo(kw.w) * zb[6], bfhi(kw.w) * zb[7]));
#pragma unroll
            for (int dt = 0; dt < 16; ++dt) { const bf16x8 vf = *(const bf16x8*)(vp + (size_t)(16 * dt) * MTOK + 32 * s);
                af[dt] = MFMA16(kf, vf, af[dt]); ab[dt] = MFMA16(kb, vf, ab[dt]); }
        }
        bf16_t* sf = ST + ((size_t)(bh * 32 + c) * 2) * 32768 + 16 * wave + 4 * fq;
#pragma unroll
        for (int dt = 0; dt < 16; ++dt) { u32x2 w; w.x = cvt_pk_bf16(af[dt][0], af[dt][1]); w.y = cvt_pk_bf16(af[dt][2], af[dt][3]); *(u32x2*)(sf + (size_t)(16 * dt + fr) * 128) = w;
            u32x2 x; x.x = cvt_pk_bf16(ab[dt][0], ab[dt][1]); x.y = cvt_pk_bf16(ab[dt][2], ab[dt][3]); *(u32x2*)(sf + 32768 + (size_t)(16 * dt + fr) * 128) = x; }
    }
}
__device__ __forceinline__ void ret_scan_phase(bf16_t* ST, const float* dec_f, const float* dec_b, int tid, int bid) {
    for (int g = bid * 512 + tid; g < 131072; g += gridDim.x * 512) {
        const int e8 = g & 4095, bhd = g >> 12, dir = bhd & 1, bh = bhd >> 1, h = bh & 3;
        const float lg = log2f(1.f / (1.f + expf(-(dir ? dec_b[h] : dec_f[h])))); const float dec = exp2f(256.f * lg);
        bf16_t* base = ST + ((size_t)(bh * 32) * 2 + dir) * 32768 + (size_t)e8 * 8;
        u32x4 v[32];
#pragma unroll
        for (int it = 0; it < 32; ++it) { const int c = dir ? 31 - it : it; v[it] = *(const u32x4*)(base + (size_t)c * 65536); }
        float S[8];
#pragma unroll
        for (int e = 0; e < 8; ++e) S[e] = 0.f;
#pragma unroll
        for (int it = 0; it < 32; ++it) { const int c = dir ? 31 - it : it;
            u32x4 w; w.x = cvt_pk_bf16(S[0], S[1]); w.y = cvt_pk_bf16(S[2], S[3]); w.z = cvt_pk_bf16(S[4], S[5]); w.w = cvt_pk_bf16(S[6], S[7]);
            *(u32x4*)(base + (size_t)c * 65536) = w;
            S[0] = S[0] * dec + bflo(v[it].x); S[1] = S[1] * dec + bfhi(v[it].x); S[2] = S[2] * dec + bflo(v[it].y); S[3] = S[3] * dec + bfhi(v[it].y);
            S[4] = S[4] * dec + bflo(v[it].z); S[5] = S[5] * dec + bfhi(v[it].z); S[6] = S[6] * dec + bflo(v[it].w); S[7] = S[7] * dec + bfhi(v[it].w); }
    }
}
__device__ __forceinline__ void ret_out_phase(const bf16_t* QR, const bf16_t* KR, const bf16_t* VT, const bf16_t* ST, bf16_t* GR, const float* dec_f, const float* dec_b, LAS unsigned char* ldsb, int wave, int lane, int bid) {
    const int fr = lane & 15, fq = lane >> 4;
    for (int unit = bid; unit < 512; unit += gridDim.x) {
        const int c = unit & 31, bh = unit >> 5, h = bh & 3, b = bh >> 2;
        const size_t tok0 = (size_t)b * SEQ + c * 256;
        const float lgf = log2f(1.f / (1.f + expf(-dec_f[h]))), lgb = log2f(1.f / (1.f + expf(-dec_b[h])));
        LAS bf16x8* qL = (LAS bf16x8*)(ldsb + wave * 8192) + lane;
#pragma unroll
        for (int mi = 0; mi < 2; ++mi)
#pragma unroll
            for (int ks = 0; ks < 4; ++ks) qL[(mi * 4 + ks) * 64] = *(const bf16x8*)(QR + (tok0 + 32 * wave + 16 * mi + fr) * 512 + h * 128 + 32 * ks + 8 * fq);
#define QF(mi, ks) (qL[((mi) * 4 + (ks)) * 64])
        f32x4 acc[16][2];
#pragma unroll
        for (int dt = 0; dt < 16; ++dt) { acc[dt][0] = (f32x4){0.f, 0.f, 0.f, 0.f}; acc[dt][1] = (f32x4){0.f, 0.f, 0.f, 0.f}; }
        const bf16_t* vbase = VT + (size_t)(h * 256 + fr) * MTOK + tok0 + 8 * fq;
        const int krow = 8 * (fr >> 2) + (fr & 3);
#pragma unroll 1
        for (int s = 0; s < 8; ++s) {
            asm volatile("" ::: "memory");
            f32x4 st[2][2];
#pragma unroll
            for (int a01 = 0; a01 < 2; ++a01) { st[a01][0] = (f32x4){0.f, 0.f, 0.f, 0.f}; st[a01][1] = (f32x4){0.f, 0.f, 0.f, 0.f};
                const bf16_t* kp = KR + (tok0 + 32 * s + krow + 4 * a01) * 512 + h * 128 + 8 * fq;
#pragma unroll
                for (int ks = 0; ks < 4; ++ks) { const bf16x8 kf = *(const bf16x8*)(kp + 32 * ks);
                    st[a01][0] = MFMA16(kf, QF(0, ks), st[a01][0]); st[a01][1] = MFMA16(kf, QF(1, ks), st[a01][1]); }
#pragma unroll
                for (int mi = 0; mi < 2; ++mi)
#pragma unroll
                    for (int v = 0; v < 4; ++v) { const int d = (32 * wave + 16 * mi + fr) - (32 * s + 8 * fq + 4 * a01 + v);
                        st[a01][mi][v] *= exp2f(d >= 0 ? lgf * (float)d : lgb * (float)(-d)); } }
            const bf16x8 pf0 = mk8(cvt_pk_bf16(st[0][0][0], st[0][0][1]), cvt_pk_bf16(st[0][0][2], st[0][0][3]), cvt_pk_bf16(st[1][0][0], st[1][0][1]), cvt_pk_bf16(st[1][0][2], st[1][0][3]));
            const bf16x8 pf1 = mk8(cvt_pk_bf16(st[0][1][0], st[0][1][1]), cvt_pk_bf16(st[0][1][2], st[0][1][3]), cvt_pk_bf16(st[1][1][0], st[1][1][1]), cvt_pk_bf16(st[1][1][2], st[1][1][3]));
#pragma unroll
            for (int dt = 0; dt < 16; ++dt) { const bf16_t* vp = vbase + (size_t)(16 * dt) * MTOK + 32 * s;
                const bf16x8 vf = *(const bf16x8*)vp;
                acc[dt][0] = MFMA16(vf, pf0, acc[dt][0]); acc[dt][1] = MFMA16(vf, pf1, acc[dt][1]); if ((dt & 7) == 7) __builtin_amdgcn_sched_barrier(0); }
        }
#pragma unroll 1
        for (int dir = 0; dir < 2; ++dir) {
            const bf16_t* sp = ST + ((size_t)(bh * 32 + c) * 2 + dir) * 32768 + (size_t)fr * 128 + 8 * fq;
            const int i0 = 32 * wave + fr;
            const float sc0 = dir ? exp2f(lgb * (float)(256 - i0)) : exp2f(lgf * (float)(i0 + 1));
            const float sc1 = dir ? exp2f(lgb * (float)(256 - i0 - 16)) : exp2f(lgf * (float)(i0 + 17));
#pragma unroll
            for (int ks = 0; ks < 4; ++ks) { asm volatile("" ::: "memory"); const bf16x8 qs0 = scale8(QF(0, ks), sc0), qs1 = scale8(QF(1, ks), sc1);
#pragma unroll
                for (int dt = 0; dt < 16; ++dt) { const bf16x8 sf = *(const bf16x8*)(sp + (size_t)(16 * dt) * 128 + 32 * ks);
                    acc[dt][0] = MFMA16(sf, qs0, acc[dt][0]); acc[dt][1] = MFMA16(sf, qs1, acc[dt][1]); if ((dt & 7) == 7) __builtin_amdgcn_sched_barrier(0); } }
        }
#pragma unroll
        for (int mi = 0; mi < 2; ++mi) {
            float sm = 0.f;
#pragma unroll
            for (int dt = 0; dt < 16; ++dt) sm += (acc[dt][mi][0] + acc[dt][mi][1]) + (acc[dt][mi][2] + acc[dt][mi][3]);
            sm += __shfl_xor(sm, 16); sm += __shfl_xor(sm, 32);
            const float mu = sm * (1.f / 256.f); float sq = 0.f;
#pragma unroll
            for (int dt = 0; dt < 16; ++dt) { const f32x4 d = acc[dt][mi] - mu; sq += (d[0] * d[0] + d[1] * d[1]) + (d[2] * d[2] + d[3] * d[3]); }
            sq += __shfl_xor(sq, 16); sq += __shfl_xor(sq, 32);
            const float rstd = 1.f / sqrtf(sq * (1.f / 256.f) + GN_EPS);
            bf16_t* gp = GR + (tok0 + 32 * wave + 16 * mi + fr) * 1024 + h * 256 + 4 * fq;
#pragma unroll
            for (int dt = 0; dt < 16; ++dt) { const u32x2 gw = *(const u32x2*)(gp + 16 * dt);
                const float g0 = bflo(gw.x), g1 = bfhi(gw.x), g2 = bflo(gw.y), g3 = bfhi(gw.y); const f32x4 o = (acc[dt][mi] - mu) * rstd;
                u32x2 w; w.x = cvt_pk_bf16(g0 * sigm(g0) * o[0], g1 * sigm(g1) * o[1]); w.y = cvt_pk_bf16(g2 * sigm(g2) * o[2], g3 * sigm(g3) * o[3]);
                *(u32x2*)(gp + 16 * dt) = w; }
        }
    }
}
#undef QF
__device__ __forceinline__ void conv_glu_phase(const bf16_t* H, bf16_t* U, int NP, int aoff, const float* cw, const float* cb, int tid, int bid) {
    const int ncg = NP / 8, nitems = (MTOK / 32) * ncg;
    for (int item = bid * 512 + tid; item < nitems; item += gridDim.x * 512) {
        const int cgp = item % ncg, strip = item / ncg, j0 = cgp * 8, t0 = strip * 32;
        float wa[3][8], wb[3][8], ba[8], bb[8];
#pragma unroll
        for (int e = 0; e < 8; ++e) {
#pragma unroll
            for (int k = 0; k < 3; ++k) { wa[k][e] = cw[k * 5632 + aoff + j0 + e]; wb[k][e] = cw[k * 5632 + 2816 + aoff + j0 + e]; }
            ba[e] = cb[aoff + j0 + e]; bb[e] = cb[2816 + aoff + j0 + e]; }
        const bf16_t* hp = H + (size_t)t0 * (2 * NP) + j0;
        u32x4 pa, pb, ca, cb_, na, nb;
        const u32x4 z4 = {0u, 0u, 0u, 0u};
        if ((t0 & (SEQ - 1)) != 0) { pa = *(const u32x4*)(hp - (size_t)(2 * NP)); pb = *(const u32x4*)(hp - (size_t)(2 * NP) + NP); } else { pa = z4; pb = z4; }
        ca = *(const u32x4*)hp; cb_ = *(const u32x4*)(hp + NP);
#pragma unroll 1
        for (int r = 0; r < 32; ++r) {
            const int t = t0 + r;
            if ((t & (SEQ - 1)) != SEQ - 1) { na = *(const u32x4*)(hp + (size_t)(r + 1) * (2 * NP)); nb = *(const u32x4*)(hp + (size_t)(r + 1) * (2 * NP) + NP); } else { na = z4; nb = z4; }
            float o[8];
#define CG_ONE(e, PW, CW, NW, PWB, CWB, NWB, LOHI) { const float a = wa[0][e] * LOHI(PW) + wa[1][e] * LOHI(CW) + wa[2][e] * LOHI(NW) + ba[e]; \
                const float bq = wb[0][e] * LOHI(PWB) + wb[1][e] * LOHI(CWB) + wb[2][e] * LOHI(NWB) + bb[e]; o[e] = gelu_tanh(a) * bq; }
            CG_ONE(0, pa.x, ca.x, na.x, pb.x, cb_.x, nb.x, bflo) CG_ONE(1, pa.x, ca.x, na.x, pb.x, cb_.x, nb.x, bfhi)
            CG_ONE(2, pa.y, ca.y, na.y, pb.y, cb_.y, nb.y, bflo) CG_ONE(3, pa.y, ca.y, na.y, pb.y, cb_.y, nb.y, bfhi)
            CG_ONE(4, pa.z, ca.z, na.z, pb.z, cb_.z, nb.z, bflo) CG_ONE(5, pa.z, ca.z, na.z, pb.z, cb_.z, nb.z, bfhi)
            CG_ONE(6, pa.w, ca.w, na.w, pb.w, cb_.w, nb.w, bflo) CG_ONE(7, pa.w, ca.w, na.w, pb.w, cb_.w, nb.w, bfhi)
#undef CG_ONE
            u32x4 w; w.x = cvt_pk_bf16(o[0], o[1]); w.y = cvt_pk_bf16(o[2], o[3]); w.z = cvt_pk_bf16(o[4], o[5]); w.w = cvt_pk_bf16(o[6], o[7]);
            *(u32x4*)(U + (size_t)t * NP + j0) = w;
            pa = ca; pb = cb_; ca = na; cb_ = nb;
        }
    }
}

#ifndef PH_MASK
#define PH_MASK 0xFFFFFFFFu
#endif
#define PH(n) ((PH_MASK >> (n)) & 1u)
struct Args { const float* in[19]; float* out; unsigned char* ws; };
constexpr int LDS_BYTES = 147456;
__device__ __forceinline__ int otid() { int t = threadIdx.x; asm volatile("" : "+v"(t)); return t; }
__device__ __forceinline__ int obid() { int b = blockIdx.x; asm volatile("" : "+s"(b)); return b; }
typedef const unsigned long long __attribute__((address_space(4)))* kptr_t;
__device__ __forceinline__ kptr_t kargs_() { kptr_t p = (kptr_t)__builtin_amdgcn_kernarg_segment_ptr(); asm volatile("" : "+s"(p)); return p; }
#define KIN(k) ((const float*)kargs_()[k])
#define KOUT ((float*)kargs_()[19])
#define KWS ((unsigned char*)kargs_()[20])
#define LOADIN(in) In in; { kptr_t kp_ = kargs_(); _Pragma("unroll") for (int i_ = 0; i_ < 19; ++i_) in.p[i_] = (const float*)kp_[i_]; }
#define TSET const int tid = otid(), lane = tid & 63, wave = __builtin_amdgcn_readfirstlane(tid >> 6), bid = obid(), gw = bid * 8 + wave, NGW = (int)gridDim.x * 8; (void)lane; (void)gw; (void)NGW; (void)tid;
#define GEMM(EpiT, Aptr, Bptr, Mv, Nv, Kv, Eobj) do { Gemm g_{(const bf16_t*)(Aptr), (const bf16_t*)(Bptr), (Mv), (Nv), (Kv)}; StaticOrder S_; S_.init((Mv), (Nv), (int)gridDim.x, obid()); \
        gemm_phase<EpiT, StaticOrder, true, true>(ldsp, g_, S_, (Eobj)); } while (0)
#define PHASE_FENCE() do { __builtin_amdgcn_fence(__ATOMIC_RELEASE, "agent"); __builtin_amdgcn_fence(__ATOMIC_ACQUIRE, "agent"); __syncthreads(); } while (0)


#define RLX_AGENT __ATOMIC_RELAXED, __HIP_MEMORY_SCOPE_AGENT
#define XB_TMO      128
#define XB_XCNT(j)  (256  + 64 * (j))
#define XB_XSUB(j)  (1280 + 64 * (j))
#define XB_XGEN(j)  (2304 + 64 * (j))
#define XB_TOP      3328
#define XB_TOPGEN   3392
#define XCD_BAR_WORDS 3456
#define XB_SPIN_CAP (1u << 18)

__device__ __forceinline__ unsigned xb_ld(unsigned* p)              { return __hip_atomic_load(p, __ATOMIC_RELAXED, __HIP_MEMORY_SCOPE_AGENT); }
__device__ __forceinline__ unsigned xb_add(unsigned* p, unsigned v) { return __hip_atomic_fetch_add(p, v, __ATOMIC_RELAXED, __HIP_MEMORY_SCOPE_AGENT); }
__device__ __forceinline__ unsigned xb_xcc_id() { return (unsigned)__builtin_amdgcn_s_getreg((3 << 11) | 20) & 0xFu; }
#define XB_SPIN(cond, bar) do { unsigned _sp = 0; while (cond) { __builtin_amdgcn_s_sleep(1); \
    if ((++_sp & 255u) == 0u) { if (xb_ld(&(bar)[XB_TMO])) break; if (_sp > XB_SPIN_CAP) { atomicAdd(&(bar)[XB_TMO], 1u); break; } } } } while (0)

struct XcdBarrier {
    unsigned* bar; unsigned x;
    volatile LAS unsigned* st;
};

__device__ __forceinline__ XcdBarrier xcd_barrier_post(unsigned* bar, volatile LAS unsigned* st) {
    XcdBarrier b; b.bar = bar; b.x = xb_xcc_id(); b.st = st;
    if (threadIdx.x == 0) (void)xb_add(&bar[XB_XCNT(b.x)], 1u);
    return b;
}
__device__ __forceinline__ void xcd_barrier_complete(unsigned* bar, unsigned x, unsigned& nloc, unsigned& nx) {
    const unsigned G = gridDim.x * gridDim.y * gridDim.z;
    unsigned sum, cnt, mine, sp = 0u;
    for (;;) {
        sum = 0u; cnt = 0u; mine = 0u;
#pragma unroll
        for (unsigned j = 0; j < 16; ++j) { const unsigned c = xb_ld(&bar[XB_XCNT(j)]); sum += c; cnt += (c > 0u) ? 1u : 0u; mine = (j == x) ? c : mine; }
        if (sum == G) break;
        __builtin_amdgcn_s_sleep(1);
        if ((++sp & 255u) == 0u) { if (xb_ld(&bar[XB_TMO])) break; if (sp > XB_SPIN_CAP) { atomicAdd(&bar[XB_TMO], 1u); break; } }
    }
    nloc = mine > 0u ? mine : 1u; nx = cnt > 0u ? cnt : 1u;
}

__device__ __forceinline__ void xcd_barrier(const XcdBarrier& b) {
    asm volatile("s_waitcnt vmcnt(0)" ::: "memory");
    __syncthreads();
    if (threadIdx.x == 0) {
        unsigned* bar = b.bar;
        __builtin_amdgcn_s_waitcnt(0);
        unsigned nloc = b.st[0], nx = b.st[1];
        if (nloc == 0u) { xcd_barrier_complete(bar, b.x, nloc, nx); b.st[0] = nloc; b.st[1] = nx; }
        const unsigned old = xb_add(&bar[XB_XSUB(b.x)], 1u);
        const unsigned gen = old / nloc;
        if (old + 1u == (gen + 1u) * nloc) {
            __builtin_amdgcn_fence(__ATOMIC_RELEASE, "agent");
            asm volatile("s_waitcnt vmcnt(0)" ::: "memory");
            const unsigned og = xb_add(&bar[XB_TOP], 1u);
            const unsigned tg = og / nx;
            if (og + 1u == (tg + 1u) * nx) xb_add(&bar[XB_TOPGEN], 1u);
            else XB_SPIN(xb_ld(&bar[XB_TOPGEN]) == tg, bar);
            __builtin_amdgcn_fence(__ATOMIC_ACQUIRE, "agent");
            xb_add(&bar[XB_XGEN(b.x)], 1u);
            asm volatile("s_waitcnt vmcnt(0)" ::: "memory");
        } else {
            XB_SPIN(xb_ld(&bar[XB_XGEN(b.x)]) == gen, bar);
            __builtin_amdgcn_fence(__ATOMIC_ACQUIRE, "agent");
            asm volatile("s_waitcnt vmcnt(0)" ::: "memory");
        }
    }
    __syncthreads();
}

#define XBAR() do { XcdBarrier b_; b_.bar = (unsigned*)KWS; b_.x = xb_xcc_id(); b_.st = (volatile LAS unsigned*)(lds + 131072 + 2048); xcd_barrier(b_); } while (0)

#ifndef PROBE_SEL
#define PROBE_SEL 0u
#endif
#ifndef PROBE_K
#define PROBE_K 8
#endif
#define STAMP(cat) do { if (PROBE_SEL != 0u) { if (blockIdx.x == 0 && threadIdx.x == 0) { volatile LAS unsigned long long* tw_ = (volatile LAS unsigned long long*)(lds + 131072 + 1024); \
        const unsigned long long t_ = __builtin_amdgcn_s_memrealtime(); if ((PROBE_SEL >> (cat)) & 1u) tw_[1] += t_ - tw_[0]; tw_[0] = t_; } } } while (0)
#define SYNC() do { XBAR(); STAMP(15); } while (0)
#define P_(off) ((bf16_t*)(KWS + (off)))
#define cosT ((float*)(KWS + WS_COS))
#define sinT ((float*)(KWS + WS_SIN))
#define Wb P_(WS_W)
#define xout KOUT
template <int layer> __device__ __forceinline__ void layer_body(unsigned char* lds, PG8_LAS unsigned char* ldsp, cg::grid_group& grid) {
        if (PH(1)) { EpiProj E{P_(WS_QNA), P_(WS_KNA), P_(WS_QR), P_(WS_KR), P_(WS_KT), P_(WS_GR), cosT, sinT}; GEMM(EpiProj, P_(WS_XB), Wb + W_IN, MTOK, 3072, 1024, E); }
        STAMP(1);
        __syncthreads();
        if (PH(2)) { EpiVT E{P_(WS_VTNA), P_(WS_VTR)}; GEMM(EpiVT, Wb + W_IN + (size_t)3072 * 1024, P_(WS_XB), 1536, MTOK, 1024, E); }
        STAMP(1);
        SYNC();
        if (PH(3)) { TSET ret_kv_phase(P_(WS_KT), P_(WS_VTR), P_(WS_ST), KIN(4) + layer * 4, KIN(5) + layer * 4, wave, lane, bid); }
        STAMP(2);
        __syncthreads();
        if (PH(4)) { TSET na_phase(P_(WS_QNA), P_(WS_KNA), P_(WS_VTNA), KIN(3) + layer * 3720, (LAS float*)lds, tid, wave, lane, bid); }
        STAMP(3);
        SYNC();
        if (PH(5)) { TSET ret_scan_phase(P_(WS_ST), KIN(4) + layer * 4, KIN(5) + layer * 4, tid, bid); }
        STAMP(4);
        SYNC();
        if (PH(6)) { TSET ret_out_phase(P_(WS_QR), P_(WS_KR), P_(WS_VTR), P_(WS_ST), P_(WS_GR), KIN(4) + layer * 4, KIN(5) + layer * 4, (LAS unsigned char*)lds, wave, lane, bid); }
        STAMP(5);
        __syncthreads();
        if (PH(7)) { EpiBf<2> E{P_(WS_GA), P_(WS_GB), 4, 1024}; GEMM(EpiBf<2>, P_(WS_XB), Wb + W_IN + (size_t)4608 * 1024, MTOK, 2048, 1024, E); }
        STAMP(6);
        SYNC();
        if (PH(8)) { EpiMerge<0> E{P_(WS_MRG), P_(WS_GA)}; GEMM(EpiMerge<0>, P_(WS_QNA), Wb + W_A, MTOK, 1024, 512, E); }
        STAMP(7);
        PHASE_FENCE();
        if (PH(9)) { EpiMerge<1> E{P_(WS_MRG), P_(WS_GB)}; GEMM(EpiMerge<1>, P_(WS_GR), Wb + W_B, MTOK, 1024, 1024, E); }
        STAMP(7);
        SYNC();
        if (PH(10)) { EpiF32<0> E{xout, layer == 0 ? KIN(0) : xout, nullptr}; GEMM(EpiF32<0>, P_(WS_MRG), Wb + W_O, MTOK, 1024, 1024, E); }
        STAMP(7);
        SYNC();
        if (PH(11)) { TSET for (int m = gw; m < MTOK; m += NGW) ln_row(xout + (size_t)m * DM, xout + (size_t)m * DM, P_(WS_XB) + (size_t)m * DM, KIN(9) + layer * DM, KIN(10) + layer * DM, lane); }
        STAMP(8);
        SYNC();
        if (PH(12)) { EpiBf<0> E{P_(WS_H), P_(WS_H), 1 << 20, 2 * FF1}; GEMM(EpiBf<0>, P_(WS_XB), Wb + W_UP, MTOK, 2 * FF1, 1024, E); }
        STAMP(9);
        __syncthreads();
        if (PH(13)) { EpiBf<2> E{P_(WS_SG), P_(WS_SG), 1 << 20, 1024}; GEMM(EpiBf<2>, P_(WS_XB), Wb + W_PG, MTOK, 1024, 1024, E); }
        STAMP(9);
        PHASE_FENCE();
        if (PH(14)) { EpiF32<1> E{xout, nullptr, P_(WS_SG)}; GEMM(EpiF32<1>, P_(WS_PB), Wb + W_PP, MTOK, 1024, 256, E); }
        STAMP(9);
        SYNC();
        if (PH(15)) { TSET conv_glu_phase(P_(WS_H), P_(WS_U), FF1, 0, KIN(12) + (size_t)layer * 3 * 5632, KIN(13) + (size_t)layer * 5632, tid, bid); }
        STAMP(10);
        SYNC();
        if (PH(16)) { EpiF32<2> E{xout, nullptr, nullptr}; GEMM(EpiF32<2>, P_(WS_U), Wb + W_D1, MTOK, 1024, FF1, E); }
        STAMP(11);
        __syncthreads();
        if (PH(17)) { EpiBf<0> E{P_(WS_H), P_(WS_H), 1 << 20, 2 * FF2}; GEMM(EpiBf<0>, P_(WS_XB), Wb + W_UP + (size_t)(2 * FF1) * 1024, MTOK, 2 * FF2, 1024, E); }
        STAMP(11);
        SYNC();
        if (PH(18)) { TSET conv_glu_phase(P_(WS_H), P_(WS_U), FF2, FF1, KIN(12) + (size_t)layer * 3 * 5632, KIN(13) + (size_t)layer * 5632, tid, bid); }
        STAMP(10);
        SYNC();
        if (PH(19)) { EpiF32<2> E{xout, nullptr, nullptr}; GEMM(EpiF32<2>, P_(WS_U), Wb + W_D2, MTOK, 1024, FF2, E); }
        STAMP(11);
        SYNC();
        if (PH(11)) { TSET for (int m = gw; m < MTOK; m += NGW) ln_row(xout + (size_t)m * DM, xout + (size_t)m * DM, P_(WS_XB) + (size_t)m * DM, KIN(17) + layer * DM, KIN(18) + layer * DM, lane); }
        STAMP(8);
        if (layer + 1 < NLAYER) { TSET if (PH(0)) { LOADIN(in) convert_layer(in, layer + 1, Wb, P_(WS_PB), (LAS float*)(lds + wave * 16384), gw, NGW, lane); } SYNC(); }
}

__global__ void __launch_bounds__(512, 2) mk_fwd(Args args) {
    extern __shared__ __attribute__((aligned(16))) unsigned char lds[];
    cg::grid_group grid = cg::this_grid();
    PG8_LAS unsigned char* ldsp = (PG8_LAS unsigned char*)lds;
    if (PROBE_SEL != 0u) { if (blockIdx.x == 0 && threadIdx.x == 0) { volatile LAS unsigned long long* tw_ = (volatile LAS unsigned long long*)(lds + 131072 + 1024); tw_[0] = __builtin_amdgcn_s_memrealtime(); tw_[1] = 0ull; } }
    if (threadIdx.x < 2) ((volatile LAS unsigned*)(lds + 131072 + 2048))[threadIdx.x] = 0u;
    __syncthreads();
    (void)xcd_barrier_post((unsigned*)KWS, (volatile LAS unsigned*)(lds + 131072 + 2048));
    { TSET
      if (PH(0)) { LOADIN(in) convert_layer(in, 0, Wb, P_(WS_PB), (LAS float*)(lds + wave * 16384), gw, NGW, lane); }
      float* cT = cosT; float* sT = sinT;
      for (int i = bid * 512 + tid; i < SEQ * 64; i += (int)gridDim.x * 512) { const int t = i >> 6, j = i & 63;
          const float inv = powf(10000.f, -(float)j * (1.f / 64.f)); const float ang = (float)t * inv; cT[i] = cosf(ang); sT[i] = sinf(ang); }
      const float* x = KIN(0); bf16_t* XB = P_(WS_XB);
      for (size_t i = (size_t)(bid * 512 + tid) * 8; i < (size_t)MTOK * DM; i += (size_t)gridDim.x * 512 * 8) { const f32x4 a = *(const f32x4*)(x + i), b = *(const f32x4*)(x + i + 4);
          u32x4 w; w.x = cvt_pk_bf16(a[0], a[1]); w.y = cvt_pk_bf16(a[2], a[3]); w.z = cvt_pk_bf16(b[0], b[1]); w.w = cvt_pk_bf16(b[2], b[3]); *(u32x4*)(XB + i) = w; } }
    grid.sync(); STAMP(15);

    layer_body<0>(lds, ldsp, grid);
    layer_body<1>(lds, ldsp, grid);
    layer_body<2>(lds, ldsp, grid);
    layer_body<3>(lds, ldsp, grid);
    if (PROBE_SEL != 0u) { if (blockIdx.x == 0 && threadIdx.x == 0) { volatile LAS unsigned long long* tw_ = (volatile LAS unsigned long long*)(lds + 131072 + 1024);
        const unsigned long long t0_ = __builtin_amdgcn_s_memrealtime(), want_ = (unsigned long long)PROBE_K * tw_[1]; while (__builtin_amdgcn_s_memrealtime() - t0_ < want_) __builtin_amdgcn_s_sleep(8); } }
}

extern "C" void kernel_launch(void* const* d_in, const int* in_sizes, int n_in, void* d_out, int out_size, void* d_ws, size_t ws_size, hipStream_t stream) {
    static int grid = 0;
    if (grid == 0) {
        if (n_in != 19 || out_size != MTOK * DM || ws_size < WS_END) { fprintf(stderr, "kernel_launch: unexpected shapes (n_in %d out %d ws %zu)\n", n_in, out_size, ws_size); grid = -1; return; }
        int dev = 0, cus = 0;
        if (hipGetDevice(&dev) != hipSuccess || hipDeviceGetAttribute(&cus, hipDeviceAttributeMultiprocessorCount, dev) != hipSuccess) { grid = -1; return; }
        if (hipFuncSetAttribute((const void*)mk_fwd, hipFuncAttributeMaxDynamicSharedMemorySize, LDS_BYTES) != hipSuccess) { fprintf(stderr, "kernel_launch: hipFuncSetAttribute failed\n"); grid = -1; return; }
        int per_cu = 0;
        if (hipOccupancyMaxActiveBlocksPerMultiprocessor(&per_cu, (const void*)mk_fwd, 512, LDS_BYTES) != hipSuccess || per_cu < 1) fprintf(stderr, "kernel_launch: occupancy query says %d\n", per_cu);
        (void)hipGetLastError();
        grid = cus;
    }
    if (grid < 0) return;
    if (hipMemsetAsync(d_ws, 0, 16384, stream) != hipSuccess) { fprintf(stderr, "kernel_launch: hipMemsetAsync failed\n"); return; }
    Args a{};
    for (int i = 0; i < 19; ++i) a.in[i] = (const float*)d_in[i];
    a.out = (float*)d_out; a.ws = (unsigned char*)d_ws;
    void* kargs[] = {&a};
    hipError_t e = hipLaunchCooperativeKernel((const void*)mk_fwd, dim3(grid), dim3(512), kargs, LDS_BYTES, stream);
    if (e != hipSuccess) fprintf(stderr, "kernel_launch: cooperative launch failed: %s (grid %d)\n", hipGetErrorString(e), grid);
}
```

```cpp
#include <hip/hip_runtime.h>
#include <hip/hip_cooperative_groups.h>
#include <cstdio>
#include <cstdint>
namespace cg = cooperative_groups;
namespace pg8 {
#define PG8_LAS __attribute__((address_space(3)))
typedef unsigned short bf16_t;
typedef short bf16x8 __attribute__((ext_vector_type(8)));
typedef float f32x4 __attribute__((ext_vector_type(4)));
typedef unsigned u32x4 __attribute__((ext_vector_type(4)));
constexpr int BM = 256, BK = 64, HALF = 128, HTB = HALF * BK * 2  , STAGE_BYTES = 8 * HTB, NXCD = 8, WGM = 8;

__host__ __device__ __forceinline__ int lds_byte(int r, int c) { const int st = (r >> 4) * 2 + (c >> 5), rr = r & 15, cc = c & 31, ob = rr * 64 + cc * 2; return st * 1024 + (ob ^ (((ob >> 9) & 1) << 5)); }
__host__ __device__ __forceinline__ void stage_rc(int b, int& R, int& C) { const int st = b / 1024, sb = b % 1024, swz = sb ^ (((sb >> 9) & 1) << 5); R = (st >> 1) * 16 + swz / 64; C = (st & 1) * 32 + (swz % 64) / 2; }
__host__ __device__ __forceinline__ int perm32(int rho) { const int n = rho >> 4, i = rho & 15; return 8 * (i >> 2) + 4 * n + (i & 3); }

struct Unit { int pm, pn; };
struct Gemm { const bf16_t* A; const bf16_t* Bt; int M, N, K; };

struct StaticOrder {
    int nM, nN, nwg, G, c;
    __host__ __device__ void init(int M, int N, int G_, int c_) { nM = M / BM; nN = N / BM; nwg = nM * nN; G = G_; c = c_; }
    __host__ __device__ bool next(int i, Unit& u) const {
        const long L = (long)i * G + c; if (L >= nwg) return false;
        int wgid = (int)L; { const int q = nwg / NXCD, r = nwg % NXCD, xcd = wgid % NXCD, off = wgid / NXCD; wgid = (xcd < r ? xcd * (q + 1) : r * (q + 1) + (xcd - r) * q) + off; }
        const int nig = WGM * nN, gid = wgid / nig, fm = gid * WGM, gsz = (nM - fm) < WGM ? (nM - fm) : WGM;
        u.pm = fm + ((wgid % nig) % gsz); u.pn = (wgid % nig) / gsz; return true;
    }
    __device__ __forceinline__ void a_ready(const Unit&) const {}
    __device__ __forceinline__ void done(const Unit&) const {}
};

__device__ __forceinline__ unsigned cvt_pk_bf16(float lo, float hi) { unsigned r; asm volatile("v_cvt_pk_bf16_f32 %0, %1, %2" : "=v"(r) : "v"(lo), "v"(hi)); return r; }
template <class Epi, class Sched, bool ALIGN_EPI = false, bool SP2 = false>
__device__ __forceinline__ void gemm_phase(PG8_LAS unsigned char* lds, const Gemm g, const Sched& S, const Epi& E) {
    int tid_raw_ = threadIdx.x; asm volatile("" : "+v"(tid_raw_)); const int tid = tid_raw_, wid = __builtin_amdgcn_readfirstlane(tid >> 6), lane = tid & 63, wr = wid >> 2, wc = wid & 3, fr = lane & 15, fq = lane >> 4;
    const int K = g.K, nt = K / BK;
    unsigned voffA[2], voffB[2];
#pragma unroll
    for (int i = 0; i < 2; ++i) { int R, C; stage_rc(tid * 16 + i * 8192, R, C); const int Rb = Epi::PERM ? ((R & ~31) + perm32(R & 31)) : R;
        voffA[i] = (unsigned)(R * K + C) * 2u; voffB[i] = (unsigned)(Rb * K + C) * 2u; }
    const size_t kstep = (size_t)(BK * 2);
    const size_t hstep = (size_t)HALF * K * 2;
    const size_t tstep = 2 * hstep;
    const unsigned ldsw = (unsigned)wid * 1024u;
    const int aoff = lds_byte(wr * 64 + fr, fq * 8), boff = lds_byte(wc * 32 + fr, fq * 8);
#define PG8_SA(b, h) (((b) * 2 + (h)) * HTB)
#define PG8_SB(b, h) ((4 + (b) * 2 + (h)) * HTB)
#define PG8_STAGE(bufoff, gbase, voff) do { _Pragma("unroll") for (int _i = 0; _i < 2; ++_i) \
        __builtin_amdgcn_global_load_lds((const unsigned*)((const char*)(gbase) + (voff)[_i]), (PG8_LAS unsigned*)(lds + (bufoff) + ldsw + _i * 8192), 16, 0, 0); } while (0)
#define PG8_LDA(dst, b, h) do { _Pragma("unroll") for (int m = 0; m < 4; ++m) _Pragma("unroll") for (int k = 0; k < 2; ++k) dst[m][k] = *(const PG8_LAS bf16x8*)(lds + PG8_SA(b, h) + aoff + m * 2048 + k * 1024); } while (0)
#define PG8_LDB(dst, b, h) do { _Pragma("unroll") for (int n = 0; n < 2; ++n) _Pragma("unroll") for (int k = 0; k < 2; ++k) dst[n][k] = *(const PG8_LAS bf16x8*)(lds + PG8_SB(b, h) + boff + n * 2048 + k * 1024); } while (0)
#define PG8_MMA(ai, bj, At, Bt) do { __builtin_amdgcn_s_setprio(1); _Pragma("unroll") for (int m = 0; m < 4; ++m) _Pragma("unroll") for (int n = 0; n < 2; ++n) _Pragma("unroll") for (int k = 0; k < 2; ++k) \
        acc[ai][bj][m][n] = __builtin_amdgcn_mfma_f32_16x16x32_bf16(Bt[n][k], At[m][k], acc[ai][bj][m][n], 0, 0, 0); __builtin_amdgcn_s_setprio(0); } while (0)
#define PG8_WAIT_V(n) asm volatile("s_waitcnt vmcnt(" #n ")" ::: "memory")
#define PG8_WAIT_L(n) asm volatile("s_waitcnt lgkmcnt(" #n ")" ::: "memory")
#define PG8_BAR __builtin_amdgcn_s_barrier()
#define PG8_SCHED __builtin_amdgcn_sched_barrier(0)
    Unit cur, nxt; int ui = 0;
    if (!S.next(0, cur)) return;
    f32x4 acc[2][2][4][2];
#pragma unroll
    for (int a = 0; a < 2; ++a)
#pragma unroll
        for (int b = 0; b < 2; ++b)
#pragma unroll
            for (int m = 0; m < 4; ++m)
#pragma unroll
                for (int n = 0; n < 2; ++n) acc[a][b][m][n] = (f32x4){0.f, 0.f, 0.f, 0.f};
    bf16x8 At[4][2], B0[2][2], B1[2][2];
    const char* cA = (const char*)g.A + (size_t)cur.pm * tstep; const char* cB = (const char*)g.Bt + (size_t)cur.pn * tstep;
    S.a_ready(cur);
    if constexpr (SP2) {
        PG8_STAGE(PG8_SB(0, 0), cB, voffB); PG8_STAGE(PG8_SB(0, 1), cB + hstep, voffB); PG8_STAGE(PG8_SA(0, 0), cA, voffA); PG8_STAGE(PG8_SA(0, 1), cA + hstep, voffA);
        if (wr == 1) PG8_BAR;
        PG8_WAIT_V(2); PG8_BAR;
        PG8_STAGE(PG8_SB(1, 0), cB + kstep, voffB); PG8_STAGE(PG8_SA(1, 0), cA + kstep, voffA); PG8_STAGE(PG8_SB(1, 1), cB + hstep + kstep, voffB);
        PG8_WAIT_V(6); PG8_BAR;
    } else {
        PG8_STAGE(PG8_SB(0, 0), cB, voffB); PG8_STAGE(PG8_SA(0, 0), cA, voffA); PG8_STAGE(PG8_SB(0, 1), cB + hstep, voffB); PG8_STAGE(PG8_SA(0, 1), cA + hstep, voffA);
        if (wr == 1) PG8_BAR;
        PG8_WAIT_V(4); PG8_BAR;
        PG8_STAGE(PG8_SB(1, 0), cB + kstep, voffB); PG8_STAGE(PG8_SA(1, 0), cA + kstep, voffA); PG8_STAGE(PG8_SB(1, 1), cB + hstep + kstep, voffB);
        PG8_WAIT_V(6); PG8_BAR;
    }
    for (;;) {
        const bool has_next = S.next(ui + 1, nxt);
        const char* nA = has_next ? (const char*)g.A + (size_t)nxt.pm * tstep : cA; const char* nB = has_next ? (const char*)g.Bt + (size_t)nxt.pn * tstep : cB;
        for (int t = 0; t < nt; t += 2) {
            const bool last = (t == nt - 2);
            const char* a1 = cA + (size_t)(t + 1) * kstep;
            const char* a2 = last ? nA : cA + (size_t)(t + 2) * kstep; const char* b2 = last ? nB : cB + (size_t)(t + 2) * kstep;
            const char* a3 = a2 + kstep; const char* b3 = b2 + kstep;
            if (last && has_next) S.a_ready(nxt);
            if constexpr (SP2) {
            PG8_LDB(B0, 0, 0); PG8_LDB(B1, 0, 1); PG8_SCHED; PG8_LDA(At, 0, 0); PG8_STAGE(PG8_SA(1, 1), a1 + hstep, voffA);
            PG8_WAIT_V(8); PG8_WAIT_L(0); PG8_BAR; PG8_MMA(0, 0, At, B0); PG8_MMA(0, 1, At, B1); PG8_BAR; PG8_SCHED;
            PG8_LDA(At, 0, 1); PG8_STAGE(PG8_SB(0, 0), b2, voffB); PG8_STAGE(PG8_SB(0, 1), b2 + hstep, voffB); PG8_STAGE(PG8_SA(0, 0), a2, voffA);
            PG8_WAIT_V(8); PG8_WAIT_L(0); PG8_BAR; PG8_MMA(1, 0, At, B0); PG8_MMA(1, 1, At, B1); PG8_BAR; PG8_SCHED;
            PG8_LDB(B0, 1, 0); PG8_LDB(B1, 1, 1); PG8_SCHED; PG8_LDA(At, 1, 0); PG8_STAGE(PG8_SA(0, 1), a2 + hstep, voffA);
            PG8_WAIT_V(8); PG8_WAIT_L(0); PG8_BAR; PG8_MMA(0, 0, At, B0); PG8_MMA(0, 1, At, B1); PG8_BAR; PG8_SCHED;
            PG8_LDA(At, 1, 1); PG8_STAGE(PG8_SB(1, 0), b3, voffB); PG8_STAGE(PG8_SB(1, 1), b3 + hstep, voffB); PG8_STAGE(PG8_SA(1, 0), a3, voffA);
            PG8_WAIT_V(8); PG8_WAIT_L(0); PG8_BAR; PG8_MMA(1, 0, At, B0); PG8_MMA(1, 1, At, B1); PG8_BAR; PG8_SCHED;
            } else {
            PG8_LDB(B0, 0, 0); PG8_SCHED; PG8_LDA(At, 0, 0); PG8_STAGE(PG8_SA(1, 1), a1 + hstep, voffA);
            PG8_WAIT_L(8); PG8_BAR; PG8_WAIT_L(0); PG8_MMA(0, 0, At, B0); PG8_BAR; PG8_SCHED;
            PG8_LDB(B1, 0, 1); PG8_STAGE(PG8_SB(0, 0), b2, voffB);
            PG8_BAR; PG8_WAIT_L(0); PG8_MMA(0, 1, At, B1); PG8_BAR;
            PG8_LDA(At, 0, 1); PG8_STAGE(PG8_SA(0, 0), a2, voffA);
            PG8_BAR; PG8_WAIT_L(0); PG8_MMA(1, 0, At, B0); PG8_BAR; PG8_SCHED;
            PG8_STAGE(PG8_SB(0, 1), b2 + hstep, voffB);
            PG8_WAIT_V(6); PG8_BAR; PG8_MMA(1, 1, At, B1); PG8_BAR;
            PG8_LDB(B0, 1, 0); PG8_SCHED; PG8_LDA(At, 1, 0); PG8_STAGE(PG8_SA(0, 1), a2 + hstep, voffA);
            PG8_WAIT_L(8); PG8_BAR; PG8_WAIT_L(0); PG8_MMA(0, 0, At, B0); PG8_BAR; PG8_SCHED;
            PG8_LDB(B1, 1, 1); PG8_STAGE(PG8_SB(1, 0), b3, voffB);
            PG8_BAR; PG8_WAIT_L(0); PG8_MMA(0, 1, At, B1); PG8_BAR;
            PG8_LDA(At, 1, 1); PG8_STAGE(PG8_SA(1, 0), a3, voffA);
            PG8_BAR; PG8_WAIT_L(0); PG8_MMA(1, 0, At, B0); PG8_BAR; PG8_SCHED;
            PG8_STAGE(PG8_SB(1, 1), b3 + hstep, voffB);
            PG8_WAIT_V(6); PG8_BAR; PG8_MMA(1, 1, At, B1); PG8_BAR;
            }
        }
        if constexpr (ALIGN_EPI) { if (wr == 0) PG8_BAR; }
        if constexpr (!Epi::AFTER_DRAIN) { E(acc, cur, wr, wc, fr, fq); S.done(cur); }
        if (!has_next) break;
#pragma unroll
        for (int a = 0; a < 2; ++a)
#pragma unroll
            for (int b = 0; b < 2; ++b)
#pragma unroll
                for (int m = 0; m < 4; ++m)
#pragma unroll
                    for (int n = 0; n < 2; ++n) acc[a][b][m][n] = (f32x4){0.f, 0.f, 0.f, 0.f};
        cur = nxt; cA = nA; cB = nB; ++ui;
        if constexpr (ALIGN_EPI) { if (wr == 1) PG8_BAR; }
    }
    PG8_WAIT_V(0);
    if constexpr (!ALIGN_EPI) { if (wr == 0) PG8_BAR; }
    PG8_BAR;
    if constexpr (Epi::AFTER_DRAIN) { E.fused(acc, cur, wr, wc, fr, fq, lds, wid, lane); S.done(cur); }
#undef PG8_SA
#undef PG8_SB
#undef PG8_STAGE
#undef PG8_LDA
#undef PG8_LDB
#undef PG8_MMA
#undef PG8_WAIT_V
#undef PG8_WAIT_L
#undef PG8_BAR
#undef PG8_SCHED
}
}

using namespace pg8;
#define LAS __attribute__((address_space(3)))
typedef unsigned u32x2 __attribute__((ext_vector_type(2)));
constexpr int MTOK = 32768, DM = 1024, SEQ = 8192, NLAYER = 4;
constexpr float ALPHA = 1.681792830507429f;
constexpr float LN_EPS = 1e-5f, GN_EPS = 1e-6f;
constexpr size_t MiB = 1u << 20;
constexpr size_t WS_COS = 1 * MiB, WS_SIN = 3 * MiB, WS_W = 6 * MiB, WS_XB = 44 * MiB, WS_QNA = 108 * MiB, WS_KNA = 140 * MiB, WS_VTNA = 172 * MiB,
                 WS_KT = 204 * MiB, WS_QR = 268 * MiB, WS_KR = 300 * MiB, WS_VTR = 332 * MiB, WS_GR = 396 * MiB, WS_ST = 460 * MiB, WS_PB = 524 * MiB,
                 WS_GA = 140 * MiB, WS_GB = 204 * MiB, WS_MRG = 268 * MiB, WS_SG = 108 * MiB, WS_H = 172 * MiB, WS_U = 364 * MiB, WS_END = 540 * MiB;
constexpr size_t W_IN = 0, W_A = W_IN + (size_t)6656 * 1024, W_B = W_A + (size_t)1024 * 512, W_O = W_B + (size_t)1024 * 1024, W_UP = W_O + (size_t)1024 * 1024,
                 W_D1 = W_UP + (size_t)5632 * 1024, W_D2 = W_D1 + (size_t)1024 * 1536, W_PG = W_D2 + (size_t)1024 * 1280, W_PP = W_PG + (size_t)1024 * 1024, W_TOTAL = W_PP + (size_t)1024 * 256;
static_assert(W_TOTAL * 2 <= 38 * MiB, "weights fit");
constexpr int FF1 = 1536, FF2 = 1280;

__device__ __forceinline__ float bflo(unsigned w) { return __uint_as_float(w << 16); }
__device__ __forceinline__ float bfhi(unsigned w) { return __uint_as_float(w & 0xffff0000u); }
__device__ __forceinline__ float sigm(float x) { return 1.f / (1.f + __expf(-x)); }
__device__ __forceinline__ float gelu_tanh(float x) { const float y = 0.7978845608028654f * (x + 0.044715f * x * x * x); const float t = 1.f - 2.f / (__expf(2.f * y) + 1.f); return 0.5f * x * (1.f + t); }
__device__ __forceinline__ bf16x8 mk8(unsigned a, unsigned b, unsigned c, unsigned d) { u32x4 w = {a, b, c, d}; return __builtin_bit_cast(bf16x8, w); }
__device__ __forceinline__ bf16x8 scale8(bf16x8 v, float s) { u32x4 w = __builtin_bit_cast(u32x4, v);
    return mk8(cvt_pk_bf16(bflo(w.x) * s, bfhi(w.x) * s), cvt_pk_bf16(bflo(w.y) * s, bfhi(w.y) * s), cvt_pk_bf16(bflo(w.z) * s, bfhi(w.z) * s), cvt_pk_bf16(bflo(w.w) * s, bfhi(w.w) * s)); }
#define MFMA16(a, b, c) __builtin_amdgcn_mfma_f32_16x16x32_bf16((a), (b), (c), 0, 0, 0)

template <int ACT> struct EpiBf {
    static constexpr bool PERM = true, AFTER_DRAIN = false;
    bf16_t* base0; bf16_t* base1; int nsplit; int ld;
    __device__ __forceinline__ void operator()(const f32x4 (&acc)[2][2][4][2], const Unit& u, int wr, int wc, int fr, int fq) const {
        bf16_t* base = (u.pn < nsplit) ? base0 + u.pn * 256 : base1 + (u.pn - nsplit) * 256;
        const int row0 = u.pm * 256 + wr * 64 + fr, col0 = wc * 32 + 8 * fq;
#pragma unroll
        for (int ai = 0; ai < 2; ++ai)
#pragma unroll
            for (int m = 0; m < 4; ++m) { bf16_t* rowp = base + (size_t)(row0 + ai * HALF + m * 16) * ld + col0;
#pragma unroll
                for (int bj = 0; bj < 2; ++bj) { f32x4 v0 = acc[ai][bj][m][0], v1 = acc[ai][bj][m][1];
                    if (ACT == 2) { v0 = (f32x4){sigm(v0[0]), sigm(v0[1]), sigm(v0[2]), sigm(v0[3])}; v1 = (f32x4){sigm(v1[0]), sigm(v1[1]), sigm(v1[2]), sigm(v1[3])}; }
                    u32x4 w; w.x = cvt_pk_bf16(v0[0], v0[1]); w.y = cvt_pk_bf16(v0[2], v0[3]); w.z = cvt_pk_bf16(v1[0], v1[1]); w.w = cvt_pk_bf16(v1[2], v1[3]);
                    *(u32x4*)(rowp + bj * HALF) = w; } }
    }
};
struct EpiVT {
    static constexpr bool PERM = true, AFTER_DRAIN = false;
    bf16_t* vtna; bf16_t* vtr;
    __device__ __forceinline__ void operator()(const f32x4 (&acc)[2][2][4][2], const Unit& u, int wr, int wc, int fr, int fq) const {
        bf16_t* base = (u.pm < 2) ? vtna + (size_t)(u.pm * 256) * MTOK : vtr + (size_t)((u.pm - 2) * 256) * MTOK;
        const int row0 = wr * 64 + fr, col0 = u.pn * 256 + wc * 32 + 8 * fq;
#pragma unroll
        for (int ai = 0; ai < 2; ++ai)
#pragma unroll
            for (int m = 0; m < 4; ++m) { bf16_t* rowp = base + (size_t)(row0 + ai * HALF + m * 16) * MTOK + col0;
#pragma unroll
                for (int bj = 0; bj < 2; ++bj) { const f32x4 v0 = acc[ai][bj][m][0], v1 = acc[ai][bj][m][1];
                    u32x4 w; w.x = cvt_pk_bf16(v0[0], v0[1]); w.y = cvt_pk_bf16(v0[2], v0[3]); w.z = cvt_pk_bf16(v1[0], v1[1]); w.w = cvt_pk_bf16(v1[2], v1[3]);
                    *(u32x4*)(rowp + bj * HALF) = w; } }
    }
};
struct EpiProj {
    static constexpr bool PERM = true, AFTER_DRAIN = false;
    bf16_t *qna, *kna, *qr, *kr, *kt, *gr; const float* cosT; const float* sinT;
    __device__ __forceinline__ void operator()(const f32x4 (&acc)[2][2][4][2], const Unit& u, int wr, int wc, int fr, int fq) const {
        const int pn = u.pn, row0 = u.pm * 256 + wr * 64 + fr;
        if (pn < 4 || pn >= 8) {
            bf16_t* base; int ld; float sc = 1.f;
            if (pn < 2) { base = qna + pn * 256; ld = 512; sc = 0.125f; } else if (pn < 4) { base = kna + (pn - 2) * 256; ld = 512; } else { base = gr + (pn - 8) * 256; ld = 1024; }
            const int col0 = wc * 32 + 8 * fq;
#pragma unroll
            for (int ai = 0; ai < 2; ++ai)
#pragma unroll
                for (int m = 0; m < 4; ++m) { bf16_t* rowp = base + (size_t)(row0 + ai * HALF + m * 16) * ld + col0;
#pragma unroll
                    for (int bj = 0; bj < 2; ++bj) { const f32x4 v0 = acc[ai][bj][m][0] * sc, v1 = acc[ai][bj][m][1] * sc;
                        u32x4 w; w.x = cvt_pk_bf16(v0[0], v0[1]); w.y = cvt_pk_bf16(v0[2], v0[3]); w.z = cvt_pk_bf16(v1[0], v1[1]); w.w = cvt_pk_bf16(v1[2], v1[3]);
                        *(u32x4*)(rowp + bj * HALF) = w; } }
        } else {
            const bool isk = pn >= 6; bf16_t* base = isk ? kr : qr; const int hb = (isk ? pn - 6 : pn - 4) * 2;
            const float sc = isk ? 0.08838834764831845f : 1.f;
            const int i4 = 4 * (4 * wc + fq);
#pragma unroll
            for (int ai = 0; ai < 2; ++ai)
#pragma unroll
                for (int m = 0; m < 4; ++m) { const int row = row0 + ai * HALF + m * 16, t = row & (SEQ - 1);
                    const f32x4 c = *(const f32x4*)(cosT + t * 64 + i4), s = *(const f32x4*)(sinT + t * 64 + i4);
#pragma unroll
                    for (int bj = 0; bj < 2; ++bj) { const int head = hb + bj; const f32x4 x1 = acc[ai][bj][m][0], x2 = acc[ai][bj][m][1];
                        const f32x4 o1 = (x1 * c - x2 * s) * sc, o2 = (x2 * c + x1 * s) * sc;
                        u32x2 w1, w2; w1.x = cvt_pk_bf16(o1[0], o1[1]); w1.y = cvt_pk_bf16(o1[2], o1[3]); w2.x = cvt_pk_bf16(o2[0], o2[1]); w2.y = cvt_pk_bf16(o2[2], o2[3]);
                        bf16_t* p = base + (size_t)row * 512 + head * 128 + i4;
                        *(u32x2*)p = w1; *(u32x2*)(p + 64) = w2;
                        if (isk) { bf16_t* q = kt + (size_t)(head * 128 + i4) * MTOK + row;
                            q[0] = (bf16_t)(w1.x & 0xffffu); q[(size_t)MTOK] = (bf16_t)(w1.x >> 16); q[(size_t)2 * MTOK] = (bf16_t)(w1.y & 0xffffu); q[(size_t)3 * MTOK] = (bf16_t)(w1.y >> 16);
                            bf16_t* q2 = q + (size_t)64 * MTOK;
                            q2[0] = (bf16_t)(w2.x & 0xffffu); q2[(size_t)MTOK] = (bf16_t)(w2.x >> 16); q2[(size_t)2 * MTOK] = (bf16_t)(w2.y & 0xffffu); q2[(size_t)3 * MTOK] = (bf16_t)(w2.y >> 16); } } }
        }
    }
};
template <int MODE> struct EpiMerge {
    static constexpr bool PERM = true, AFTER_DRAIN = false;
    bf16_t* mrg; const bf16_t* gate;
    __device__ __forceinline__ void operator()(const f32x4 (&acc)[2][2][4][2], const Unit& u, int wr, int wc, int fr, int fq) const {
        const int row0 = u.pm * 256 + wr * 64 + fr, col0 = u.pn * 256 + wc * 32 + 8 * fq;
#pragma unroll
        for (int ai = 0; ai < 2; ++ai)
#pragma unroll
            for (int m = 0; m < 4; ++m) { const size_t off = (size_t)(row0 + ai * HALF + m * 16) * 1024 + col0;
#pragma unroll
                for (int bj = 0; bj < 2; ++bj) { const f32x4 v0 = acc[ai][bj][m][0], v1 = acc[ai][bj][m][1];
                    const u32x4 g = *(const u32x4*)(gate + off + bj * HALF);
                    float r0 = bflo(g.x) * v0[0], r1 = bfhi(g.x) * v0[1], r2 = bflo(g.y) * v0[2], r3 = bfhi(g.y) * v0[3], r4 = bflo(g.z) * v1[0], r5 = bfhi(g.z) * v1[1], r6 = bflo(g.w) * v1[2], r7 = bfhi(g.w) * v1[3];
                    if (MODE == 1) { const u32x4 p = *(const u32x4*)(mrg + off + bj * HALF);
                        r0 += bflo(p.x); r1 += bfhi(p.x); r2 += bflo(p.y); r3 += bfhi(p.y); r4 += bflo(p.z); r5 += bfhi(p.z); r6 += bflo(p.w); r7 += bfhi(p.w); }
                    u32x4 w; w.x = cvt_pk_bf16(r0, r1); w.y = cvt_pk_bf16(r2, r3); w.z = cvt_pk_bf16(r4, r5); w.w = cvt_pk_bf16(r6, r7);
                    *(u32x4*)(mrg + off + bj * HALF) = w; } }
    }
};
template <int MODE> struct EpiF32 {
    static constexpr bool PERM = false, AFTER_DRAIN = false;
    float* out; const float* res; const bf16_t* sg;
    __device__ __forceinline__ void operator()(const f32x4 (&acc)[2][2][4][2], const Unit& u, int wr, int wc, int fr, int fq) const {
        const int row0 = u.pm * 256 + wr * 64 + fr, col0 = u.pn * 256 + wc * 32 + 4 * fq;
#pragma unroll
        for (int ai = 0; ai < 2; ++ai)
#pragma unroll
            for (int m = 0; m < 4; ++m) { const size_t off = (size_t)(row0 + ai * HALF + m * 16) * 1024 + col0;
#pragma unroll
                for (int bj = 0; bj < 2; ++bj)
#pragma unroll
                    for (int n = 0; n < 2; ++n) { const size_t o = off + bj * HALF + n * 16; const f32x4 a = acc[ai][bj][m][n]; f32x4 r;
                        if (MODE == 0) { r = *(const f32x4*)(res + o) * ALPHA + a; }
                        else if (MODE == 1) { const u32x2 g = *(const u32x2*)(sg + o); const f32x4 gv = {bflo(g.x), bfhi(g.x), bflo(g.y), bfhi(g.y)}; r = *(const f32x4*)(out + o) * ALPHA + gv * a; }
                        else { r = *(const f32x4*)(out + o) + a; }
                        *(f32x4*)(out + o) = r; } }
    }
};

__device__ __forceinline__ float wave_sum(float v) {
#pragma unroll
    for (int o = 1; o < 64; o <<= 1) v += __shfl_xor(v, o);
    return v;
}
__device__ __forceinline__ int rotp(int x) { const int head = x >> 7, d = x & 127, i = (d & 63) >> 2, e = d & 3; return head * 128 + 8 * i + ((d >> 6) << 2) + e; }
__device__ __forceinline__ int map_win(int n) {
    if (n < 1024) return n;
    if (n < 1536) return 3072 + (n - 1024);
    if (n < 2048) return 1024 + rotp(n - 1536);
    if (n < 2560) return 1536 + rotp(n - 2048);
    if (n < 3584) return 3584 + (n - 2560);
    if (n < 4608) return 2048 + (n - 3584);
    return n;
}
__device__ __forceinline__ int map_wup(int n) {
    const bool a = n < 2816; const int j = a ? n : n - 2816;
    if (j < FF1) return (a ? 0 : FF1) + j;
    return 2 * FF1 + (a ? 0 : FF2) + (j - FF1);
}
template <int MAP> __device__ __forceinline__ void transpose_item(const float* W, int N, int k0, int n0, bf16_t* dst, int dstK, int kbase, LAS float* scr, int lane) {
#pragma unroll 8
    for (int i = 0; i < 32; ++i) { const int kk = 2 * i + (lane >> 5); scr[kk * 33 + (lane & 31)] = W[(size_t)(k0 + kk) * N + n0 + (lane & 31)]; }
    asm volatile("s_waitcnt lgkmcnt(0)" ::: "memory");
    const int c = lane & 7;
#pragma unroll
    for (int j = 0; j < 4; ++j) { const int n = (lane >> 3) + 8 * j; const LAS float* s = scr + (8 * c) * 33 + n;
        u32x4 o; o.x = cvt_pk_bf16(s[0 * 33], s[1 * 33]); o.y = cvt_pk_bf16(s[2 * 33], s[3 * 33]); o.z = cvt_pk_bf16(s[4 * 33], s[5 * 33]); o.w = cvt_pk_bf16(s[6 * 33], s[7 * 33]);
        const int sn = n0 + n; const int dr = (MAP == 1) ? map_win(sn) : (MAP == 2) ? map_wup(sn) : sn;
        *(u32x4*)(dst + (size_t)dr * dstK + (k0 - kbase) + 8 * c) = o; }
    asm volatile("s_waitcnt lgkmcnt(0)" ::: "memory");
}
struct In { const float* p[19]; };
__device__ __forceinline__ void convert_layer(const In& in, int layer, bf16_t* Wb, bf16_t* PB, LAS float* scr, int gw, int NGW, int lane) {
    const float* w_in = in.p[2] + (size_t)layer * 1024 * 6656; const float* w_a = in.p[6] + (size_t)layer * 512 * 1024; const float* w_b = in.p[7] + (size_t)layer * 1024 * 1024;
    const float* w_o = in.p[8] + (size_t)layer * 1024 * 1024; const float* w_up = in.p[11] + (size_t)layer * 1024 * 5632; const float* w_dn = in.p[14] + (size_t)layer * 2816 * 1024;
    const float* w_pg = in.p[15] + (size_t)layer * 1024 * 1024; const float* w_pp = in.p[16] + (size_t)layer * 256 * 1024;
    constexpr int I_IN = 16 * 208, I_A = 8 * 32, I_B = 16 * 32, I_O = 16 * 32, I_UP = 16 * 176, I_D1 = 24 * 32, I_D2 = 20 * 32, I_PG = 16 * 32, I_PP = 4 * 32;
    constexpr int NIT = I_IN + I_A + I_B + I_O + I_UP + I_D1 + I_D2 + I_PG + I_PP;
    for (int it = gw; it < NIT; it += NGW) {
        int r = it;
        if (r < I_IN) { transpose_item<1>(w_in, 6656, 64 * (r / 208), 32 * (r % 208), Wb + W_IN, 1024, 0, scr, lane); continue; } r -= I_IN;
        if (r < I_A) { transpose_item<0>(w_a, 1024, 64 * (r / 32), 32 * (r % 32), Wb + W_A, 512, 0, scr, lane); continue; } r -= I_A;
        if (r < I_B) { transpose_item<0>(w_b, 1024, 64 * (r / 32), 32 * (r % 32), Wb + W_B, 1024, 0, scr, lane); continue; } r -= I_B;
        if (r < I_O) { transpose_item<0>(w_o, 1024, 64 * (r / 32), 32 * (r % 32), Wb + W_O, 1024, 0, scr, lane); continue; } r -= I_O;
        if (r < I_UP) { transpose_item<2>(w_up, 5632, 64 * (r / 176), 32 * (r % 176), Wb + W_UP, 1024, 0, scr, lane); continue; } r -= I_UP;
        if (r < I_D1) { transpose_item<0>(w_dn, 1024, 64 * (r / 32), 32 * (r % 32), Wb + W_D1, FF1, 0, scr, lane); continue; } r -= I_D1;
        if (r < I_D2) { transpose_item<0>(w_dn, 1024, FF1 + 64 * (r / 32), 32 * (r % 32), Wb + W_D2, FF2, FF1, scr, lane); continue; } r -= I_D2;
        if (r < I_PG) { transpose_item<0>(w_pg, 1024, 64 * (r / 32), 32 * (r % 32), Wb + W_PG, 1024, 0, scr, lane); continue; } r -= I_PG;
        transpose_item<0>(w_pp, 1024, 64 * (r / 32), 32 * (r % 32), Wb + W_PP, 256, 0, scr, lane);
    }
    const float* ps = in.p[1] + (size_t)layer * MTOK * 256;
    for (int i = gw; i < MTOK * 256 / 512; i += NGW) { const size_t e = (size_t)i * 512 + lane * 8; const f32x4 a = *(const f32x4*)(ps + e), b = *(const f32x4*)(ps + e + 4);
        u32x4 w; w.x = cvt_pk_bf16(a[0], a[1]); w.y = cvt_pk_bf16(a[2], a[3]); w.z = cvt_pk_bf16(b[0], b[1]); w.w = cvt_pk_bf16(b[2], b[3]); *(u32x4*)(PB + e) = w; }
}
__device__ __forceinline__ void ln_row(const float* src, float* dst, bf16_t* xb, const float* g, const float* b, int lane) {
    const f32x4* xr = (const f32x4*)src + lane; f32x4 v[4]; float s = 0.f;
#pragma unroll
    for (int j = 0; j < 4; ++j) { v[j] = xr[64 * j]; s += (v[j][0] + v[j][1]) + (v[j][2] + v[j][3]); }
    const float mean = wave_sum(s) * (1.f / DM); float s2 = 0.f;
#pragma unroll
    for (int j = 0; j < 4; ++j) { v[j] = v[j] - mean; s2 += (v[j][0] * v[j][0] + v[j][1] * v[j][1]) + (v[j][2] * v[j][2] + v[j][3] * v[j][3]); }
    const float rstd = 1.f / sqrtf(wave_sum(s2) * (1.f / DM) + LN_EPS);
#pragma unroll
    for (int j = 0; j < 4; ++j) { const f32x4 gg = ((const f32x4*)g)[lane + 64 * j], bb = ((const f32x4*)b)[lane + 64 * j]; const f32x4 o = v[j] * rstd * gg + bb;
        ((f32x4*)dst)[lane + 64 * j] = o; u32x2 w; w.x = cvt_pk_bf16(o[0], o[1]); w.y = cvt_pk_bf16(o[2], o[3]); ((u32x2*)xb)[lane + 64 * j] = w; }
}

__device__ __forceinline__ void na_phase(bf16_t* QNA, const bf16_t* KNA, const bf16_t* VT, const float* rpb, LAS unsigned char* ldsb, int tid, int wave, int lane, int bid) {
    const int fr = lane & 15, fq = lane >> 4, hd = wave >> 2, j = wave & 3;
    LAS float* rpbL = (LAS float*)(ldsb + 135168);
    u32x4 stg[16];
#define NA_ISSUE_K(unit_) do { const int hp_ = (unit_) & 3, r_ = ((unit_) >> 2) & 127, b_ = (unit_) >> 9; const int rs_ = min(max(r_ - 4, 0), 120); \
        const bf16_t* kb_ = KNA + (size_t)(b_ * SEQ + rs_ * 64) * 512 + hp_ * 128; \
        _Pragma("unroll") for (int i = 0; i < 16; ++i) { const int idx = i * 512 + tid; stg[i] = *(const u32x4*)(kb_ + (size_t)(idx >> 4) * 512 + (idx & 15) * 8); } } while (0)
    if (bid < 2048) NA_ISSUE_K(bid);
    for (int unit = bid; unit < 2048; unit += gridDim.x) {
        const int hp = unit & 3, r = (unit >> 2) & 127, b = unit >> 9, h = 2 * hp + hd;
        const int tq = b * SEQ + r * 64 + 16 * j;
        const int rs = min(max(r - 4, 0), 120), c0 = min(max(16 * j - 8, 0), 32);
        const int qcol = 16 * j + fr, cs = min(max(qcol - 8, 0), 48);
        bf16_t* qp = QNA + (size_t)(tq + fr) * 512 + h * 64;
        const bf16x8 qf0 = *(const bf16x8*)(qp + 8 * fq), qf1 = *(const bf16x8*)(qp + 32 + 8 * fq);
        for (int i = tid; i < 930; i += 512) rpbL[i] = rpb[hp * 930 + i];
        { LAS unsigned char* kw_ = ldsb + ((tid & 15) >> 3) * 65536 + (tid >> 4) * 128 + (((tid & 7) ^ ((tid >> 5) & 7)) * 16);
#pragma unroll
          for (int i = 0; i < 16; ++i) *(LAS u32x4*)(kw_ + i * 4096) = stg[i]; }
        __syncthreads();
        { const bf16_t* vb_ = VT + (size_t)(hp * 128) * MTOK + (size_t)b * SEQ + rs * 64;
#pragma unroll
          for (int i = 0; i < 8; ++i) { const int idx = i * 512 + tid; stg[i] = *(const u32x4*)(vb_ + (size_t)(idx >> 6) * MTOK + ((idx >> 3) & 7) * 64 + (idx & 7) * 8); } }
        f32x4 s[16]; float mx = -INFINITY;
#pragma unroll
        for (int a = 0; a < 16; ++a) { const int kr = a >> 1;
            const int col = c0 + 8 * (fr >> 2) + 4 * (a & 1) + (fr & 3);
            const LAS unsigned char* kp = ldsb + (hd * 512 + kr * 64 + col) * 128; const int sw = (col >> 1) & 7;
            const bf16x8 kf0 = *(const LAS bf16x8*)(kp + ((fq ^ sw) * 16)), kf1 = *(const LAS bf16x8*)(kp + (((4 + fq) ^ sw) * 16));
            f32x4 acc = {0.f, 0.f, 0.f, 0.f}; acc = MFMA16(kf0, qf0, acc); acc = MFMA16(kf1, qf1, acc);
            const LAS float* bp = rpbL + hd * 465 + (rs + kr - r + 7) * 31;
#pragma unroll
            for (int v = 0; v < 4; ++v) { const int kcol = c0 + 8 * fq + 4 * (a & 1) + v; const bool valid = (kcol >= cs) && (kcol < cs + 16);
                const int bi = min(max(kcol - qcol + 15, 0), 30);
                const float sv = valid ? acc[v] + bp[bi] : -INFINITY; s[a][v] = sv; mx = fmaxf(mx, sv); }
            if ((a & 3) == 3) __builtin_amdgcn_sched_barrier(0); }
        mx = fmaxf(mx, __shfl_xor(mx, 16)); mx = fmaxf(mx, __shfl_xor(mx, 32));
        float l = 0.f;
#pragma unroll
        for (int a = 0; a < 16; ++a)
#pragma unroll
            for (int v = 0; v < 4; ++v) { const float p = __expf(s[a][v] - mx); s[a][v] = p; l += p; }
        l += __shfl_xor(l, 16); l += __shfl_xor(l, 32);
        const float rl = 1.f / l;
        bf16x8 pf[8];
#pragma unroll
        for (int ks = 0; ks < 8; ++ks) pf[ks] = mk8(cvt_pk_bf16(s[2 * ks][0], s[2 * ks][1]), cvt_pk_bf16(s[2 * ks][2], s[2 * ks][3]), cvt_pk_bf16(s[2 * ks + 1][0], s[2 * ks + 1][1]), cvt_pk_bf16(s[2 * ks + 1][2], s[2 * ks + 1][3]));
        { const bf16_t* vb_ = VT + (size_t)(hp * 128) * MTOK + (size_t)b * SEQ + rs * 64;
#pragma unroll
          for (int i = 8; i < 16; ++i) { const int idx = i * 512 + tid; stg[i] = *(const u32x4*)(vb_ + (size_t)(idx >> 6) * MTOK + ((idx >> 3) & 7) * 64 + (idx & 7) * 8); } }
        __syncthreads();
        { const int d0_ = tid >> 6, ch_ = (tid & 7) ^ (d0_ >> 1);
          LAS unsigned char* vw_ = ldsb + ((tid >> 3) & 7) * 16384 + d0_ * 128;
#pragma unroll
          for (int i = 0; i < 16; ++i) *(LAS u32x4*)(vw_ + i * 1024 + (((i & 1) ? (ch_ ^ 4) : ch_) * 16)) = stg[i]; }
        __syncthreads();
        if (unit + (int)gridDim.x < 2048) NA_ISSUE_K(unit + (int)gridDim.x);
        f32x4 o[4];
#pragma unroll
        for (int dt = 0; dt < 4; ++dt) o[dt] = (f32x4){0.f, 0.f, 0.f, 0.f};
        const int cch = (c0 >> 3) + fq;
#pragma unroll
        for (int ks = 0; ks < 8; ++ks)
#pragma unroll
            for (int dt = 0; dt < 4; ++dt) { const int dd = hd * 64 + 16 * dt + fr;
                const bf16x8 vf = *(const LAS bf16x8*)(ldsb + (ks * 128 + dd) * 128 + ((cch ^ ((dd >> 1) & 7)) * 16));
                o[dt] = MFMA16(vf, pf[ks], o[dt]); if (dt == 3 && (ks & 1)) __builtin_amdgcn_sched_barrier(0); }
#pragma unroll
        for (int dt = 0; dt < 4; ++dt) { u32x2 w; w.x = cvt_pk_bf16(o[dt][0] * rl, o[dt][1] * rl); w.y = cvt_pk_bf16(o[dt][2] * rl, o[dt][3] * rl);
            *(u32x2*)(qp + 16 * dt + 4 * fq) = w; }
        __syncthreads();
    }
#undef NA_ISSUE_K
}

__device__ __forceinline__ void ret_kv_phase(const bf16_t* KT, const bf16_t* VT, bf16_t* ST, const float* dec_f, const float* dec_b, LAS unsigned char* ldsb, int tid, int wave, int lane, int bid) {
    const int fr = lane & 15, fq = lane >> 4;
    constexpr int VBUF = 20480;
    for (int unit = bid; unit < 512; unit += gridDim.x) {
        const int c = unit & 31, bh = unit >> 5, h = bh & 3, b = bh >> 2;
        const size_t tok0 = (size_t)b * SEQ + c * 256;
        const float lgf = log2f(1.f / (1.f + expf(-dec_f[h]))), lgb = log2f(1.f / (1.f + expf(-dec_b[h])));
        f32x4 af[16], ab[16];
#pragma unroll
        for (int dt = 0; dt < 16; ++dt) { af[dt] = (f32x4){0.f, 0.f, 0.f, 0.f}; ab[dt] = (f32x4){0.f, 0.f, 0.f, 0.f}; }
        const bf16_t* kp = KT + (size_t)(h * 128 + 16 * wave + fr) * MTOK + tok0 + 8 * fq;
        const bf16_t* vg0 = VT + (size_t)(h * 256 + (tid >> 2)) * MTOK + tok0 + 8 * (tid & 3);
        const bf16_t* vg1 = vg0 + (size_t)128 * MTOK;
        const int vl0 = (tid >> 2) * 80 + (tid & 3) * 16, vl1 = vl0 + 128 * 80;
        u32x4 rv0 = *(const u32x4*)vg0, rv1 = *(const u32x4*)vg1;
        __syncthreads();
        *(LAS u32x4*)(ldsb + vl0) = rv0; *(LAS u32x4*)(ldsb + vl1) = rv1;
        __syncthreads();
#pragma unroll 1
        for (int s = 0; s < 8; ++s) {
            LAS unsigned char* cur = ldsb + (s & 1) * VBUF; LAS unsigned char* nxt = ldsb + ((s + 1) & 1) * VBUF;
            if (s < 7) { rv0 = *(const u32x4*)(vg0 + 32 * (s + 1)); rv1 = *(const u32x4*)(vg1 + 32 * (s + 1)); }
            const u32x4 kw = *(const u32x4*)(kp + 32 * s);
            const int j0 = 32 * s + 8 * fq;
            float zf[8], zb[8];
#pragma unroll
            for (int e = 0; e < 8; ++e) { zf[e] = exp2f(lgf * (float)(255 - j0 - e)); zb[e] = exp2f(lgb * (float)(j0 + e)); }
            const bf16x8 kf = mk8(cvt_pk_bf16(bflo(kw.x) * zf[0], bfhi(kw.x) * zf[1]), cvt_pk_bf16(bflo(kw.y) * zf[2], bfhi(kw.y) * zf[3]), cvt_pk_bf16(bflo(kw.z) * zf[4], bfhi(kw.z) * zf[5]), cvt_pk_bf16(bflo(kw.w) * zf[6], bfhi(kw.w) * zf[7]));
            const bf16x8 kb = mk8(cvt_pk_bf16(bflo(kw.x) * zb[0], bfhi(kw.x) * zb[1]), cvt_pk_bf16(bflo(kw.y) * zb[2], bfhi(kw.y) * zb[3]), cvt_pk_bf16(bflo(kw.z) * zb[4], bfhi(kw.z) * zb[5]), cvt_pk_bf16(bflo(kw.w) * zb[6], bfhi(kw.w) * zb[7]));
            const LAS unsigned char* vp = cur + fr * 80 + 16 * fq;
#pragma unroll
            for (int dt = 0; dt < 16; ++dt) { const bf16x8 vf = *(const LAS bf16x8*)(vp + dt * 1280);
                af[dt] = MFMA16(kf, vf, af[dt]); ab[dt] = MFMA16(kb, vf, ab[dt]); }
            if (s < 7) { *(LAS u32x4*)(nxt + vl0) = rv0; *(LAS u32x4*)(nxt + vl1) = rv1; }
            __syncthreads();
        }
        bf16_t* sf = ST + ((size_t)(bh * 32 + c) * 2) * 32768 + 16 * wave + 4 * fq;
#pragma unroll
        for (int dt = 0; dt < 16; ++dt) { u32x2 w; w.x = cvt_pk_bf16(af[dt][0], af[dt][1]); w.y = cvt_pk_bf16(af[dt][2], af[dt][3]); *(u32x2*)(sf + (size_t)(16 * dt + fr) * 128) = w;
            u32x2 x; x.x = cvt_pk_bf16(ab[dt][0], ab[dt][1]); x.y = cvt_pk_bf16(ab[dt][2], ab[dt][3]); *(u32x2*)(sf + 32768 + (size_t)(16 * dt + fr) * 128) = x; }
    }
    __syncthreads();
}
__device__ __forceinline__ void ret_scan_phase(bf16_t* ST, const float* dec_f, const float* dec_b, int tid, int bid) {
    for (int g = bid * 512 + tid; g < 131072; g += gridDim.x * 512) {
        const int e8 = g & 4095, bhd = g >> 12, dir = bhd & 1, bh = bhd >> 1, h = bh & 3;
        const float lg = log2f(1.f / (1.f + expf(-(dir ? dec_b[h] : dec_f[h])))); const float dec = exp2f(256.f * lg);
        bf16_t* base = ST + ((size_t)(bh * 32) * 2 + dir) * 32768 + (size_t)e8 * 8;
        u32x4 v[32];
#pragma unroll
        for (int it = 0; it < 32; ++it) { const int c = dir ? 31 - it : it; v[it] = *(const u32x4*)(base + (size_t)c * 65536); }
        float S[8];
#pragma unroll
        for (int e = 0; e < 8; ++e) S[e] = 0.f;
#pragma unroll
        for (int it = 0; it < 32; ++it) { const int c = dir ? 31 - it : it;
            u32x4 w; w.x = cvt_pk_bf16(S[0], S[1]); w.y = cvt_pk_bf16(S[2], S[3]); w.z = cvt_pk_bf16(S[4], S[5]); w.w = cvt_pk_bf16(S[6], S[7]);
            *(u32x4*)(base + (size_t)c * 65536) = w;
            S[0] = S[0] * dec + bflo(v[it].x); S[1] = S[1] * dec + bfhi(v[it].x); S[2] = S[2] * dec + bflo(v[it].y); S[3] = S[3] * dec + bfhi(v[it].y);
            S[4] = S[4] * dec + bflo(v[it].z); S[5] = S[5] * dec + bfhi(v[it].z); S[6] = S[6] * dec + bflo(v[it].w); S[7] = S[7] * dec + bfhi(v[it].w); }
    }
}
__device__ __forceinline__ void ret_out_phase(const bf16_t* QR, const bf16_t* KR, const bf16_t* VT, const bf16_t* ST, bf16_t* GR, const float* dec_f, const float* dec_b, LAS unsigned char* ldsb, int tid, int wave, int lane, int bid) {
    const int fr = lane & 15, fq = lane >> 4;
    constexpr int KSL = 8704, SBUF = 29184, SOFF = 65536;
    for (int unit = bid; unit < 512; unit += gridDim.x) {
        const int c = unit & 31, bh = unit >> 5, h = bh & 3, b = bh >> 2;
        const size_t tok0 = (size_t)b * SEQ + c * 256;
        const float lgf = log2f(1.f / (1.f + expf(-dec_f[h]))), lgb = log2f(1.f / (1.f + expf(-dec_b[h])));
        LAS bf16x8* qL = (LAS bf16x8*)(ldsb + wave * 8192) + lane;
#pragma unroll
        for (int mi = 0; mi < 2; ++mi)
#pragma unroll
            for (int ks = 0; ks < 4; ++ks) qL[(mi * 4 + ks) * 64] = *(const bf16x8*)(QR + (tok0 + 32 * wave + 16 * mi + fr) * 512 + h * 128 + 32 * ks + 8 * fq);
#define QF(mi, ks) (qL[((mi) * 4 + (ks)) * 64])
        f32x4 acc[16][2];
#pragma unroll
        for (int dt = 0; dt < 16; ++dt) { acc[dt][0] = (f32x4){0.f, 0.f, 0.f, 0.f}; acc[dt][1] = (f32x4){0.f, 0.f, 0.f, 0.f}; }
        const bf16_t* kg = KR + (tok0 + (tid >> 4)) * 512 + h * 128 + (tid & 15) * 8;
        const int kl = (tid >> 4) * 272 + (tid & 15) * 16;
        const bf16_t* vg0 = VT + (size_t)(h * 256 + (tid >> 2)) * MTOK + tok0 + 8 * (tid & 3);
        const bf16_t* vg1 = vg0 + (size_t)128 * MTOK;
        const int vl0 = KSL + (tid >> 2) * 80 + (tid & 3) * 16, vl1 = vl0 + 128 * 80;
        const int krow = 8 * (fr >> 2) + (fr & 3);
        u32x4 rk = *(const u32x4*)kg, rv0 = *(const u32x4*)vg0, rv1 = *(const u32x4*)vg1;
        __syncthreads();
        *(LAS u32x4*)(ldsb + SOFF + kl) = rk; *(LAS u32x4*)(ldsb + SOFF + vl0) = rv0; *(LAS u32x4*)(ldsb + SOFF + vl1) = rv1;
        __syncthreads();
#pragma unroll 1
        for (int s = 0; s < 8; ++s) {
            LAS unsigned char* cur = ldsb + SOFF + (s & 1) * SBUF; LAS unsigned char* nxt = ldsb + SOFF + ((s + 1) & 1) * SBUF;
            if (s < 7) { rk = *(const u32x4*)(kg + (size_t)(32 * (s + 1)) * 512); rv0 = *(const u32x4*)(vg0 + 32 * (s + 1)); rv1 = *(const u32x4*)(vg1 + 32 * (s + 1)); }
            f32x4 st[2][2];
#pragma unroll
            for (int a01 = 0; a01 < 2; ++a01) { st[a01][0] = (f32x4){0.f, 0.f, 0.f, 0.f}; st[a01][1] = (f32x4){0.f, 0.f, 0.f, 0.f};
                const LAS unsigned char* kp = cur + (krow + 4 * a01) * 272 + 16 * fq;
#pragma unroll
                for (int ks = 0; ks < 4; ++ks) { const bf16x8 kf = *(const LAS bf16x8*)(kp + 64 * ks);
                    st[a01][0] = MFMA16(kf, QF(0, ks), st[a01][0]); st[a01][1] = MFMA16(kf, QF(1, ks), st[a01][1]); }
#pragma unroll
                for (int mi = 0; mi < 2; ++mi)
#pragma unroll
                    for (int v = 0; v < 4; ++v) { const int d = (32 * wave + 16 * mi + fr) - (32 * s + 8 * fq + 4 * a01 + v);
                        st[a01][mi][v] *= exp2f(d >= 0 ? lgf * (float)d : lgb * (float)(-d)); } }
            const bf16x8 pf0 = mk8(cvt_pk_bf16(st[0][0][0], st[0][0][1]), cvt_pk_bf16(st[0][0][2], st[0][0][3]), cvt_pk_bf16(st[1][0][0], st[1][0][1]), cvt_pk_bf16(st[1][0][2], st[1][0][3]));
            const bf16x8 pf1 = mk8(cvt_pk_bf16(st[0][1][0], st[0][1][1]), cvt_pk_bf16(st[0][1][2], st[0][1][3]), cvt_pk_bf16(st[1][1][0], st[1][1][1]), cvt_pk_bf16(st[1][1][2], st[1][1][3]));
            const LAS unsigned char* vp = cur + KSL + fr * 80 + 16 * fq;
#pragma unroll
            for (int dt = 0; dt < 16; ++dt) { const bf16x8 vf = *(const LAS bf16x8*)(vp + dt * 1280);
                acc[dt][0] = MFMA16(vf, pf0, acc[dt][0]); acc[dt][1] = MFMA16(vf, pf1, acc[dt][1]); }
            if (s < 7) { *(LAS u32x4*)(nxt + kl) = rk; *(LAS u32x4*)(nxt + vl0) = rv0; *(LAS u32x4*)(nxt + vl1) = rv1; }
            __syncthreads();
        }
        const bf16_t* sg0 = ST + ((size_t)(bh * 32 + c) * 2) * 32768 + (size_t)(tid >> 2) * 128 + 8 * (tid & 3);
        const bf16_t* sg1 = sg0 + (size_t)128 * 128;
        rv0 = *(const u32x4*)sg0; rv1 = *(const u32x4*)sg1;
        *(LAS u32x4*)(ldsb + SOFF + vl0) = rv0; *(LAS u32x4*)(ldsb + SOFF + vl1) = rv1;
        __syncthreads();
        const int i0 = 32 * wave + fr;
#pragma unroll 1
        for (int z = 0; z < 8; ++z) {
            LAS unsigned char* cur = ldsb + SOFF + (z & 1) * SBUF; LAS unsigned char* nxt = ldsb + SOFF + ((z + 1) & 1) * SBUF;
            const int dir = z >> 2, ks = z & 3;
            if (z < 7) { const int z1 = z + 1; const size_t o = (size_t)(z1 >> 2) * 32768 + 32 * (z1 & 3); rv0 = *(const u32x4*)(sg0 + o); rv1 = *(const u32x4*)(sg1 + o); }
            const float sc0 = dir ? exp2f(lgb * (float)(256 - i0)) : exp2f(lgf * (float)(i0 + 1));
            const float sc1 = dir ? exp2f(lgb * (float)(256 - i0 - 16)) : exp2f(lgf * (float)(i0 + 17));
            const bf16x8 qs0 = scale8(qL[ks * 64], sc0), qs1 = scale8(qL[(4 + ks) * 64], sc1);
            const LAS unsigned char* sp = cur + KSL + fr * 80 + 16 * fq;
#pragma unroll
            for (int dt = 0; dt < 16; ++dt) { const bf16x8 sf = *(const LAS bf16x8*)(sp + dt * 1280);
                acc[dt][0] = MFMA16(sf, qs0, acc[dt][0]); acc[dt][1] = MFMA16(sf, qs1, acc[dt][1]); }
            if (z < 7) { *(LAS u32x4*)(nxt + vl0) = rv0; *(LAS u32x4*)(nxt + vl1) = rv1; }
            __syncthreads();
        }
#pragma unroll
        for (int mi = 0; mi < 2; ++mi) {
            float sm = 0.f;
#pragma unroll
            for (int dt = 0; dt < 16; ++dt) sm += (acc[dt][mi][0] + acc[dt][mi][1]) + (acc[dt][mi][2] + acc[dt][mi][3]);
            sm += __shfl_xor(sm, 16); sm += __shfl_xor(sm, 32);
            const float mu = sm * (1.f / 256.f); float sq = 0.f;
#pragma unroll
            for (int dt = 0; dt < 16; ++dt) { const f32x4 d = acc[dt][mi] - mu; sq += (d[0] * d[0] + d[1] * d[1]) + (d[2] * d[2] + d[3] * d[3]); }
            sq += __shfl_xor(sq, 16); sq += __shfl_xor(sq, 32);
            const float rstd = 1.f / sqrtf(sq * (1.f / 256.f) + GN_EPS);
            bf16_t* gp = GR + (tok0 + 32 * wave + 16 * mi + fr) * 1024 + h * 256 + 4 * fq;
#pragma unroll
            for (int dt = 0; dt < 16; ++dt) { const u32x2 gw = *(const u32x2*)(gp + 16 * dt);
                const float g0 = bflo(gw.x), g1 = bfhi(gw.x), g2 = bflo(gw.y), g3 = bfhi(gw.y); const f32x4 o = (acc[dt][mi] - mu) * rstd;
                u32x2 w; w.x = cvt_pk_bf16(g0 * sigm(g0) * o[0], g1 * sigm(g1) * o[1]); w.y = cvt_pk_bf16(g2 * sigm(g2) * o[2], g3 * sigm(g3) * o[3]);
                *(u32x2*)(gp + 16 * dt) = w; }
        }
    }
    __syncthreads();
}
#undef QF
template <int RS> __device__ __forceinline__ void conv_glu_phase(const bf16_t* H, bf16_t* U, int NP, int aoff, const float* cw, const float* cb, int tid, int bid) {
    const int ncg = NP / 8, nitems = (MTOK / RS) * ncg;
    for (int item = bid * 512 + tid; item < nitems; item += gridDim.x * 512) {
        const int cgp = item % ncg, strip = item / ncg, j0 = cgp * 8, t0 = strip * RS;
        float wa[3][8], wb[3][8], ba[8], bb[8];
#pragma unroll
        for (int e = 0; e < 8; ++e) {
#pragma unroll
            for (int k = 0; k < 3; ++k) { wa[k][e] = cw[k * 5632 + aoff + j0 + e]; wb[k][e] = cw[k * 5632 + 2816 + aoff + j0 + e]; }
            ba[e] = cb[aoff + j0 + e]; bb[e] = cb[2816 + aoff + j0 + e]; }
        const bf16_t* hp = H + (size_t)t0 * (2 * NP) + j0;
        u32x4 pa, pb, ca, cb_, na, nb;
        const u32x4 z4 = {0u, 0u, 0u, 0u};
        if ((t0 & (SEQ - 1)) != 0) { pa = *(const u32x4*)(hp - (size_t)(2 * NP)); pb = *(const u32x4*)(hp - (size_t)(2 * NP) + NP); } else { pa = z4; pb = z4; }
        ca = *(const u32x4*)hp; cb_ = *(const u32x4*)(hp + NP);
#pragma unroll 1
        for (int r = 0; r < RS; ++r) {
            const int t = t0 + r;
            if ((t & (SEQ - 1)) != SEQ - 1) { na = *(const u32x4*)(hp + (size_t)(r + 1) * (2 * NP)); nb = *(const u32x4*)(hp + (size_t)(r + 1) * (2 * NP) + NP); } else { na = z4; nb = z4; }
            float o[8];
#define CG_ONE(e, PW, CW, NW, PWB, CWB, NWB, LOHI) { const float a = wa[0][e] * LOHI(PW) + wa[1][e] * LOHI(CW) + wa[2][e] * LOHI(NW) + ba[e]; \
                const float bq = wb[0][e] * LOHI(PWB) + wb[1][e] * LOHI(CWB) + wb[2][e] * LOHI(NWB) + bb[e]; o[e] = gelu_tanh(a) * bq; }
            CG_ONE(0, pa.x, ca.x, na.x, pb.x, cb_.x, nb.x, bflo) CG_ONE(1, pa.x, ca.x, na.x, pb.x, cb_.x, nb.x, bfhi)
            CG_ONE(2, pa.y, ca.y, na.y, pb.y, cb_.y, nb.y, bflo) CG_ONE(3, pa.y, ca.y, na.y, pb.y, cb_.y, nb.y, bfhi)
            CG_ONE(4, pa.z, ca.z, na.z, pb.z, cb_.z, nb.z, bflo) CG_ONE(5, pa.z, ca.z, na.z, pb.z, cb_.z, nb.z, bfhi)
            CG_ONE(6, pa.w, ca.w, na.w, pb.w, cb_.w, nb.w, bflo) CG_ONE(7, pa.w, ca.w, na.w, pb.w, cb_.w, nb.w, bfhi)
#undef CG_ONE
            u32x4 w; w.x = cvt_pk_bf16(o[0], o[1]); w.y = cvt_pk_bf16(o[2], o[3]); w.z = cvt_pk_bf16(o[4], o[5]); w.w = cvt_pk_bf16(o[6], o[7]);
            *(u32x4*)(U + (size_t)t * NP + j0) = w;
            pa = ca; pb = cb_; ca = na; cb_ = nb;
        }
    }
}

#ifndef PH_MASK
#define PH_MASK 0xFFFFFFFFu
#endif
#define PH(n) ((PH_MASK >> (n)) & 1u)
struct Args { const float* in[19]; float* out; unsigned char* ws; };
constexpr int LDS_BYTES = 147456;
__device__ __forceinline__ int otid() { int t = threadIdx.x; asm volatile("" : "+v"(t)); return t; }
__device__ __forceinline__ int obid() { int b = blockIdx.x; asm volatile("" : "+s"(b)); return b; }
typedef const unsigned long long __attribute__((address_space(4)))* kptr_t;
__device__ __forceinline__ kptr_t kargs_() { kptr_t p = (kptr_t)__builtin_amdgcn_kernarg_segment_ptr(); asm volatile("" : "+s"(p)); return p; }
#define KIN(k) ((const float*)kargs_()[k])
#define KOUT ((float*)kargs_()[19])
#define KWS ((unsigned char*)kargs_()[20])
#define LOADIN(in) In in; { kptr_t kp_ = kargs_(); _Pragma("unroll") for (int i_ = 0; i_ < 19; ++i_) in.p[i_] = (const float*)kp_[i_]; }
#define TSET const int tid = otid(), lane = tid & 63, wave = __builtin_amdgcn_readfirstlane(tid >> 6), bid = obid(), gw = bid * 8 + wave, NGW = (int)gridDim.x * 8; (void)lane; (void)gw; (void)NGW; (void)tid;
#define GEMM(EpiT, Aptr, Bptr, Mv, Nv, Kv, Eobj) do { Gemm g_{(const bf16_t*)(Aptr), (const bf16_t*)(Bptr), (Mv), (Nv), (Kv)}; StaticOrder S_; S_.init((Mv), (Nv), (int)gridDim.x, obid()); \
        gemm_phase<EpiT, StaticOrder, true, true>(ldsp, g_, S_, (Eobj)); } while (0)
#define PHASE_FENCE() do { __builtin_amdgcn_fence(__ATOMIC_RELEASE, "agent"); __builtin_amdgcn_fence(__ATOMIC_ACQUIRE, "agent"); __syncthreads(); } while (0)


#define RLX_AGENT __ATOMIC_RELAXED, __HIP_MEMORY_SCOPE_AGENT
#define XB_TMO      128
#define XB_XCNT(j)  (256  + 64 * (j))
#define XB_XSUB(j)  (1280 + 64 * (j))
#define XB_XGEN(j)  (2304 + 64 * (j))
#define XB_TOP      3328
#define XB_TOPGEN   3392
#define XCD_BAR_WORDS 3456
#define XB_SPIN_CAP (1u << 18)

__device__ __forceinline__ unsigned xb_ld(unsigned* p)              { return __hip_atomic_load(p, __ATOMIC_RELAXED, __HIP_MEMORY_SCOPE_AGENT); }
__device__ __forceinline__ unsigned xb_add(unsigned* p, unsigned v) { return __hip_atomic_fetch_add(p, v, __ATOMIC_RELAXED, __HIP_MEMORY_SCOPE_AGENT); }
__device__ __forceinline__ unsigned xb_xcc_id() { return (unsigned)__builtin_amdgcn_s_getreg((3 << 11) | 20) & 0xFu; }
#define XB_SPIN(cond, bar) do { unsigned _sp = 0; while (cond) { __builtin_amdgcn_s_sleep(1); \
    if ((++_sp & 255u) == 0u) { if (xb_ld(&(bar)[XB_TMO])) break; if (_sp > XB_SPIN_CAP) { atomicAdd(&(bar)[XB_TMO], 1u); break; } } } } while (0)

struct XcdBarrier {
    unsigned* bar; unsigned x;
    volatile LAS unsigned* st;
};

__device__ __forceinline__ XcdBarrier xcd_barrier_post(unsigned* bar, volatile LAS unsigned* st) {
    XcdBarrier b; b.bar = bar; b.x = xb_xcc_id(); b.st = st;
    if (threadIdx.x == 0) (void)xb_add(&bar[XB_XCNT(b.x)], 1u);
    return b;
}
__device__ __forceinline__ void xcd_barrier_complete(unsigned* bar, unsigned x, unsigned& nloc, unsigned& nx) {
    const unsigned G = gridDim.x * gridDim.y * gridDim.z;
    unsigned sum, cnt, mine, sp = 0u;
    for (;;) {
        sum = 0u; cnt = 0u; mine = 0u;
#pragma unroll
        for (unsigned j = 0; j < 16; ++j) { const unsigned c = xb_ld(&bar[XB_XCNT(j)]); sum += c; cnt += (c > 0u) ? 1u : 0u; mine = (j == x) ? c : mine; }
        if (sum == G) break;
        __builtin_amdgcn_s_sleep(1);
        if ((++sp & 255u) == 0u) { if (xb_ld(&bar[XB_TMO])) break; if (sp > XB_SPIN_CAP) { atomicAdd(&bar[XB_TMO], 1u); break; } }
    }
    nloc = mine > 0u ? mine : 1u; nx = cnt > 0u ? cnt : 1u;
}

__device__ __forceinline__ void xcd_barrier(const XcdBarrier& b) {
    asm volatile("s_waitcnt vmcnt(0)" ::: "memory");
    __syncthreads();
    if (threadIdx.x == 0) {
        unsigned* bar = b.bar;
        __builtin_amdgcn_s_waitcnt(0);
        unsigned nloc = b.st[0], nx = b.st[1];
        if (nloc == 0u) { xcd_barrier_complete(bar, b.x, nloc, nx); b.st[0] = nloc; b.st[1] = nx; }
        const unsigned old = xb_add(&bar[XB_XSUB(b.x)], 1u);
        const unsigned gen = old / nloc;
        if (old + 1u == (gen + 1u) * nloc) {
            __builtin_amdgcn_fence(__ATOMIC_RELEASE, "agent");
            asm volatile("s_waitcnt vmcnt(0)" ::: "memory");
            const unsigned og = xb_add(&bar[XB_TOP], 1u);
            const unsigned tg = og / nx;
            if (og + 1u == (tg + 1u) * nx) xb_add(&bar[XB_TOPGEN], 1u);
            else XB_SPIN(xb_ld(&bar[XB_TOPGEN]) == tg, bar);
            __builtin_amdgcn_fence(__ATOMIC_ACQUIRE, "agent");
            xb_add(&bar[XB_XGEN(b.x)], 1u);
            asm volatile("s_waitcnt vmcnt(0)" ::: "memory");
        } else {
            XB_SPIN(xb_ld(&bar[XB_XGEN(b.x)]) == gen, bar);
            __builtin_amdgcn_fence(__ATOMIC_ACQUIRE, "agent");
            asm volatile("s_waitcnt vmcnt(0)" ::: "memory");
        }
    }
    __syncthreads();
}

#define XBAR() do { XcdBarrier b_; b_.bar = (unsigned*)KWS; b_.x = xb_xcc_id(); b_.st = (volatile LAS unsigned*)(lds + 131072 + 2048); xcd_barrier(b_); } while (0)

#ifndef PROBE_SEL
#define PROBE_SEL 0u
#endif
#ifndef PROBE_K
#define PROBE_K 8
#endif
#define STAMP(cat) do { if (PROBE_SEL != 0u) { if (blockIdx.x == 0 && threadIdx.x == 0) { volatile LAS unsigned long long* tw_ = (volatile LAS unsigned long long*)(lds + 131072 + 1024); \
        const unsigned long long t_ = __builtin_amdgcn_s_memrealtime(); if ((PROBE_SEL >> (cat)) & 1u) tw_[1] += t_ - tw_[0]; tw_[0] = t_; } } } while (0)
#define SYNC() do { XBAR(); STAMP(15); } while (0)
#define P_(off) ((bf16_t*)(KWS + (off)))
#define cosT ((float*)(KWS + WS_COS))
#define sinT ((float*)(KWS + WS_SIN))
#define Wb P_(WS_W)
#define xout KOUT
template <int layer> __device__ __forceinline__ void layer_body(unsigned char* lds, PG8_LAS unsigned char* ldsp, cg::grid_group& grid) {
        if (PH(1)) { EpiProj E{P_(WS_QNA), P_(WS_KNA), P_(WS_QR), P_(WS_KR), P_(WS_KT), P_(WS_GR), cosT, sinT}; GEMM(EpiProj, P_(WS_XB), Wb + W_IN, MTOK, 3072, 1024, E); }
        STAMP(1);
        __syncthreads();
        if (PH(2)) { EpiVT E{P_(WS_VTNA), P_(WS_VTR)}; GEMM(EpiVT, Wb + W_IN + (size_t)3072 * 1024, P_(WS_XB), 1536, MTOK, 1024, E); }
        STAMP(1);
        SYNC();
        if (PH(3)) { TSET ret_kv_phase(P_(WS_KT), P_(WS_VTR), P_(WS_ST), KIN(4) + layer * 4, KIN(5) + layer * 4, (LAS unsigned char*)lds, tid, wave, lane, bid); }
        STAMP(2);
        __syncthreads();
        if (PH(4)) { TSET na_phase(P_(WS_QNA), P_(WS_KNA), P_(WS_VTNA), KIN(3) + layer * 3720, (LAS unsigned char*)lds, tid, wave, lane, bid); }
        STAMP(3);
        SYNC();
        if (PH(5)) { TSET ret_scan_phase(P_(WS_ST), KIN(4) + layer * 4, KIN(5) + layer * 4, tid, bid); }
        STAMP(4);
        SYNC();
        if (PH(6)) { TSET ret_out_phase(P_(WS_QR), P_(WS_KR), P_(WS_VTR), P_(WS_ST), P_(WS_GR), KIN(4) + layer * 4, KIN(5) + layer * 4, (LAS unsigned char*)lds, tid, wave, lane, bid); }
        STAMP(5);
        __syncthreads();
        if (PH(7)) { EpiBf<2> E{P_(WS_GA), P_(WS_GB), 4, 1024}; GEMM(EpiBf<2>, P_(WS_XB), Wb + W_IN + (size_t)4608 * 1024, MTOK, 2048, 1024, E); }
        STAMP(6);
        SYNC();
        if (PH(8)) { EpiMerge<0> E{P_(WS_MRG), P_(WS_GA)}; GEMM(EpiMerge<0>, P_(WS_QNA), Wb + W_A, MTOK, 1024, 512, E); }
        STAMP(7);
        PHASE_FENCE();
        if (PH(9)) { EpiMerge<1> E{P_(WS_MRG), P_(WS_GB)}; GEMM(EpiMerge<1>, P_(WS_GR), Wb + W_B, MTOK, 1024, 1024, E); }
        STAMP(7);
        SYNC();
        if (PH(10)) { EpiF32<0> E{xout, layer == 0 ? KIN(0) : xout, nullptr}; GEMM(EpiF32<0>, P_(WS_MRG), Wb + W_O, MTOK, 1024, 1024, E); }
        STAMP(7);
        SYNC();
        if (PH(11)) { TSET for (int m = gw; m < MTOK; m += NGW) ln_row(xout + (size_t)m * DM, xout + (size_t)m * DM, P_(WS_XB) + (size_t)m * DM, KIN(9) + layer * DM, KIN(10) + layer * DM, lane); }
        STAMP(8);
        SYNC();
        if (PH(12)) { EpiBf<0> E{P_(WS_H), P_(WS_H), 1 << 20, 2 * FF1}; GEMM(EpiBf<0>, P_(WS_XB), Wb + W_UP, MTOK, 2 * FF1, 1024, E); }
        STAMP(9);
        __syncthreads();
        if (PH(13)) { EpiBf<2> E{P_(WS_SG), P_(WS_SG), 1 << 20, 1024}; GEMM(EpiBf<2>, P_(WS_XB), Wb + W_PG, MTOK, 1024, 1024, E); }
        STAMP(9);
        PHASE_FENCE();
        if (PH(14)) { EpiF32<1> E{xout, nullptr, P_(WS_SG)}; GEMM(EpiF32<1>, P_(WS_PB), Wb + W_PP, MTOK, 1024, 256, E); }
        STAMP(9);
        SYNC();
        if (PH(15)) { TSET conv_glu_phase<16>(P_(WS_H), P_(WS_U), FF1, 0, KIN(12) + (size_t)layer * 3 * 5632, KIN(13) + (size_t)layer * 5632, tid, bid); }
        STAMP(10);
        SYNC();
        if (PH(16)) { EpiF32<2> E{xout, nullptr, nullptr}; GEMM(EpiF32<2>, P_(WS_U), Wb + W_D1, MTOK, 1024, FF1, E); }
        STAMP(11);
        __syncthreads();
        if (PH(17)) { EpiBf<0> E{P_(WS_H), P_(WS_H), 1 << 20, 2 * FF2}; GEMM(EpiBf<0>, P_(WS_XB), Wb + W_UP + (size_t)(2 * FF1) * 1024, MTOK, 2 * FF2, 1024, E); }
        STAMP(11);
        SYNC();
        if (PH(18)) { TSET conv_glu_phase<8>(P_(WS_H), P_(WS_U), FF2, FF1, KIN(12) + (size_t)layer * 3 * 5632, KIN(13) + (size_t)layer * 5632, tid, bid); }
        STAMP(10);
        SYNC();
        if (PH(19)) { EpiF32<2> E{xout, nullptr, nullptr}; GEMM(EpiF32<2>, P_(WS_U), Wb + W_D2, MTOK, 1024, FF2, E); }
        STAMP(11);
        SYNC();
        if (PH(11)) { TSET for (int m = gw; m < MTOK; m += NGW) ln_row(xout + (size_t)m * DM, xout + (size_t)m * DM, P_(WS_XB) + (size_t)m * DM, KIN(17) + layer * DM, KIN(18) + layer * DM, lane); }
        STAMP(8);
        if (layer + 1 < NLAYER) { TSET if (PH(0)) { LOADIN(in) convert_layer(in, layer + 1, Wb, P_(WS_PB), (LAS float*)(lds + wave * 16384), gw, NGW, lane); } SYNC(); }
}

__global__ void __launch_bounds__(512, 2) mk_fwd(Args args) {
    extern __shared__ __attribute__((aligned(16))) unsigned char lds[];
    cg::grid_group grid = cg::this_grid();
    PG8_LAS unsigned char* ldsp = (PG8_LAS unsigned char*)lds;
    if (PROBE_SEL != 0u) { if (blockIdx.x == 0 && threadIdx.x == 0) { volatile LAS unsigned long long* tw_ = (volatile LAS unsigned long long*)(lds + 131072 + 1024); tw_[0] = __builtin_amdgcn_s_memrealtime(); tw_[1] = 0ull; } }
    if (threadIdx.x < 2) ((volatile LAS unsigned*)(lds + 131072 + 2048))[threadIdx.x] = 0u;
    __syncthreads();
    (void)xcd_barrier_post((unsigned*)KWS, (volatile LAS unsigned*)(lds + 131072 + 2048));
    { TSET
      if (PH(0)) { LOADIN(in) convert_layer(in, 0, Wb, P_(WS_PB), (LAS float*)(lds + wave * 16384), gw, NGW, lane); }
      float* cT = cosT; float* sT = sinT;
      for (int i = bid * 512 + tid; i < SEQ * 64; i += (int)gridDim.x * 512) { const int t = i >> 6, j = i & 63;
          const float inv = powf(10000.f, -(float)j * (1.f / 64.f)); const float ang = (float)t * inv; cT[i] = cosf(ang); sT[i] = sinf(ang); }
      const float* x = KIN(0); bf16_t* XB = P_(WS_XB);
      for (size_t i = (size_t)(bid * 512 + tid) * 8; i < (size_t)MTOK * DM; i += (size_t)gridDim.x * 512 * 8) { const f32x4 a = *(const f32x4*)(x + i), b = *(const f32x4*)(x + i + 4);
          u32x4 w; w.x = cvt_pk_bf16(a[0], a[1]); w.y = cvt_pk_bf16(a[2], a[3]); w.z = cvt_pk_bf16(b[0], b[1]); w.w = cvt_pk_bf16(b[2], b[3]); *(u32x4*)(XB + i) = w; } }
    grid.sync(); STAMP(15);

    layer_body<0>(lds, ldsp, grid);
    layer_body<1>(lds, ldsp, grid);
    layer_body<2>(lds, ldsp, grid);
    layer_body<3>(lds, ldsp, grid);
    if (PROBE_SEL != 0u) { if (blockIdx.x == 0 && threadIdx.x == 0) { volatile LAS unsigned long long* tw_ = (volatile LAS unsigned long long*)(lds + 131072 + 1024);
        const unsigned long long t0_ = __builtin_amdgcn_s_memrealtime(), want_ = (unsigned long long)PROBE_K * tw_[1]; while (__builtin_amdgcn_s_memrealtime() - t0_ < want_) __builtin_amdgcn_s_sleep(8); } }
}

extern "C" void kernel_launch(void* const* d_in, const int* in_sizes, int n_in, void* d_out, int out_size, void* d_ws, size_t ws_size, hipStream_t stream) {
    static int grid = 0;
    if (grid == 0) {
        if (n_in != 19 || out_size != MTOK * DM || ws_size < WS_END) { fprintf(stderr, "kernel_launch: unexpected shapes (n_in %d out %d ws %zu)\n", n_in, out_size, ws_size); grid = -1; return; }
        int dev = 0, cus = 0;
        if (hipGetDevice(&dev) != hipSuccess || hipDeviceGetAttribute(&cus, hipDeviceAttributeMultiprocessorCount, dev) != hipSuccess) { grid = -1; return; }
        if (hipFuncSetAttribute((const void*)mk_fwd, hipFuncAttributeMaxDynamicSharedMemorySize, LDS_BYTES) != hipSuccess) { fprintf(stderr, "kernel_launch: hipFuncSetAttribute failed\n"); grid = -1; return; }
        int per_cu = 0;
        if (hipOccupancyMaxActiveBlocksPerMultiprocessor(&per_cu, (const void*)mk_fwd, 512, LDS_BYTES) != hipSuccess || per_cu < 1) fprintf(stderr, "kernel_launch: occupancy query says %d\n", per_cu);
        (void)hipGetLastError();
        grid = cus;
    }
    if (grid < 0) return;
    if (hipMemsetAsync(d_ws, 0, 16384, stream) != hipSuccess) { fprintf(stderr, "kernel_launch: hipMemsetAsync failed\n"); return; }
    Args a{};
    for (int i = 0; i < 19; ++i) a.in[i] = (const float*)d_in[i];
    a.out = (float*)d_out; a.ws = (unsigned char*)d_ws;
    void* kargs[] = {&a};
    hipError_t e = hipLaunchCooperativeKernel((const void*)mk_fwd, dim3(grid), dim3(512), kargs, LDS_BYTES, stream);
    if (e != hipSuccess) fprintf(stderr, "kernel_launch: cooperative launch failed: %s (grid %d)\n", hipGetErrorString(e), grid);
}
```

```cpp
#include <hip/hip_runtime.h>
#include <hip/hip_cooperative_groups.h>
#include <cstdio>
#include <cstdint>
namespace cg = cooperative_groups;
namespace pg8 {
#define PG8_LAS __attribute__((address_space(3)))
typedef unsigned short bf16_t;
typedef short bf16x8 __attribute__((ext_vector_type(8)));
typedef float f32x4 __attribute__((ext_vector_type(4)));
typedef unsigned u32x4 __attribute__((ext_vector_type(4)));
constexpr int BM = 256, BK = 64, HALF = 128, HTB = HALF * BK * 2  , STAGE_BYTES = 8 * HTB, NXCD = 8, WGM = 8;

__host__ __device__ __forceinline__ int lds_byte(int r, int c) { const int st = (r >> 4) * 2 + (c >> 5), rr = r & 15, cc = c & 31, ob = rr * 64 + cc * 2; return st * 1024 + (ob ^ (((ob >> 9) & 1) << 5)); }
__host__ __device__ __forceinline__ void stage_rc(int b, int& R, int& C) { const int st = b / 1024, sb = b % 1024, swz = sb ^ (((sb >> 9) & 1) << 5); R = (st >> 1) * 16 + swz / 64; C = (st & 1) * 32 + (swz % 64) / 2; }
__host__ __device__ __forceinline__ int perm32(int rho) { const int n = rho >> 4, i = rho & 15; return 8 * (i >> 2) + 4 * n + (i & 3); }

struct Unit { int pm, pn; };
struct Gemm { const bf16_t* A; const bf16_t* Bt; int M, N, K; };

struct StaticOrder {
    int nM, nN, nwg, G, c;
    __host__ __device__ void init(int M, int N, int G_, int c_) { nM = M / BM; nN = N / BM; nwg = nM * nN; G = G_; c = c_; }
    __host__ __device__ bool next(int i, Unit& u) const {
        const long L = (long)i * G + c; if (L >= nwg) return false;
        int wgid = (int)L; { const int q = nwg / NXCD, r = nwg % NXCD, xcd = wgid % NXCD, off = wgid / NXCD; wgid = (xcd < r ? xcd * (q + 1) : r * (q + 1) + (xcd - r) * q) + off; }
        const int nig = WGM * nN, gid = wgid / nig, fm = gid * WGM, gsz = (nM - fm) < WGM ? (nM - fm) : WGM;
        u.pm = fm + ((wgid % nig) % gsz); u.pn = (wgid % nig) / gsz; return true;
    }
    __device__ __forceinline__ void a_ready(const Unit&) const {}
    __device__ __forceinline__ void done(const Unit&) const {}
};

__device__ __forceinline__ unsigned cvt_pk_bf16(float lo, float hi) { unsigned r; asm volatile("v_cvt_pk_bf16_f32 %0, %1, %2" : "=v"(r) : "v"(lo), "v"(hi)); return r; }
template <class Epi, class Sched, bool ALIGN_EPI = false, bool SP2 = false, bool CONVA = false>
__device__ __forceinline__ void gemm_phase(PG8_LAS unsigned char* lds, const Gemm g, const Sched& S, const Epi& E) {
    int tid_raw_ = threadIdx.x; asm volatile("" : "+v"(tid_raw_)); const int tid = tid_raw_, wid = __builtin_amdgcn_readfirstlane(tid >> 6), lane = tid & 63, wr = wid >> 2, wc = wid & 3, fr = lane & 15, fq = lane >> 4;
    const int K = g.K, nt = K / BK;
    unsigned voffA[2], voffB[2];
#pragma unroll
    for (int i = 0; i < 2; ++i) { int R, C; stage_rc(tid * 16 + i * 8192, R, C); const int Rb = Epi::PERM ? ((R & ~31) + perm32(R & 31)) : R;
        const int Ra = CONVA ? (126 * (R >> 6) + 8 * (R & 15) + ((R >> 4) & 3)) : R;
        voffA[i] = (unsigned)(Ra * K + C) * 2u; voffB[i] = (unsigned)(Rb * K + C) * 2u; }
    const size_t kstep = (size_t)(BK * 2);
    const size_t hstep = (size_t)HALF * K * 2;
    const size_t tstep = 2 * hstep; const size_t hstepA = CONVA ? (size_t)4 * K * 2 : hstep;
    const unsigned ldsw = (unsigned)wid * 1024u;
    const int aoff = lds_byte(wr * 64 + fr, fq * 8), boff = lds_byte(wc * 32 + fr, fq * 8);
#define PG8_SA(b, h) (((b) * 2 + (h)) * HTB)
#define PG8_SB(b, h) ((4 + (b) * 2 + (h)) * HTB)
#define PG8_STAGE(bufoff, gbase, voff) do { _Pragma("unroll") for (int _i = 0; _i < 2; ++_i) \
        __builtin_amdgcn_global_load_lds((const unsigned*)((const char*)(gbase) + (voff)[_i]), (PG8_LAS unsigned*)(lds + (bufoff) + ldsw + _i * 8192), 16, 0, 0); } while (0)
#define PG8_LDA(dst, b, h) do { _Pragma("unroll") for (int m = 0; m < 4; ++m) _Pragma("unroll") for (int k = 0; k < 2; ++k) dst[m][k] = *(const PG8_LAS bf16x8*)(lds + PG8_SA(b, h) + aoff + m * 2048 + k * 1024); } while (0)
#define PG8_LDB(dst, b, h) do { _Pragma("unroll") for (int n = 0; n < 2; ++n) _Pragma("unroll") for (int k = 0; k < 2; ++k) dst[n][k] = *(const PG8_LAS bf16x8*)(lds + PG8_SB(b, h) + boff + n * 2048 + k * 1024); } while (0)
#define PG8_MMA(ai, bj, At, Bt) do { __builtin_amdgcn_s_setprio(1); _Pragma("unroll") for (int m = 0; m < 4; ++m) _Pragma("unroll") for (int n = 0; n < 2; ++n) _Pragma("unroll") for (int k = 0; k < 2; ++k) \
        acc[ai][bj][m][n] = __builtin_amdgcn_mfma_f32_16x16x32_bf16(Bt[n][k], At[m][k], acc[ai][bj][m][n], 0, 0, 0); __builtin_amdgcn_s_setprio(0); } while (0)
#define PG8_WAIT_V(n) asm volatile("s_waitcnt vmcnt(" #n ")" ::: "memory")
#define PG8_WAIT_L(n) asm volatile("s_waitcnt lgkmcnt(" #n ")" ::: "memory")
#define PG8_BAR __builtin_amdgcn_s_barrier()
#define PG8_SCHED __builtin_amdgcn_sched_barrier(0)
    Unit cur, nxt; int ui = 0;
    if (!S.next(0, cur)) return;
    f32x4 acc[2][2][4][2];
#pragma unroll
    for (int a = 0; a < 2; ++a)
#pragma unroll
        for (int b = 0; b < 2; ++b)
#pragma unroll
            for (int m = 0; m < 4; ++m)
#pragma unroll
                for (int n = 0; n < 2; ++n) acc[a][b][m][n] = (f32x4){0.f, 0.f, 0.f, 0.f};
    bf16x8 At[4][2], B0[2][2], B1[2][2];
    const char* cA = CONVA ? (const char*)g.A + ((long)((cur.pm / 33) * 8192 + 252 * (cur.pm % 33) - 1)) * (long)(K * 2) : (const char*)g.A + (size_t)cur.pm * tstep; const char* cB = (const char*)g.Bt + (size_t)cur.pn * tstep;
    S.a_ready(cur);
    if constexpr (SP2) {
        PG8_STAGE(PG8_SB(0, 0), cB, voffB); PG8_STAGE(PG8_SB(0, 1), cB + hstep, voffB); PG8_STAGE(PG8_SA(0, 0), cA, voffA); PG8_STAGE(PG8_SA(0, 1), cA + hstepA, voffA);
        if (wr == 1) PG8_BAR;
        PG8_WAIT_V(2); PG8_BAR;
        PG8_STAGE(PG8_SB(1, 0), cB + kstep, voffB); PG8_STAGE(PG8_SA(1, 0), cA + kstep, voffA); PG8_STAGE(PG8_SB(1, 1), cB + hstep + kstep, voffB);
        PG8_WAIT_V(6); PG8_BAR;
    } else {
        PG8_STAGE(PG8_SB(0, 0), cB, voffB); PG8_STAGE(PG8_SA(0, 0), cA, voffA); PG8_STAGE(PG8_SB(0, 1), cB + hstep, voffB); PG8_STAGE(PG8_SA(0, 1), cA + hstepA, voffA);
        if (wr == 1) PG8_BAR;
        PG8_WAIT_V(4); PG8_BAR;
        PG8_STAGE(PG8_SB(1, 0), cB + kstep, voffB); PG8_STAGE(PG8_SA(1, 0), cA + kstep, voffA); PG8_STAGE(PG8_SB(1, 1), cB + hstep + kstep, voffB);
        PG8_WAIT_V(6); PG8_BAR;
    }
    for (;;) {
        const bool has_next = S.next(ui + 1, nxt);
        const char* nA = has_next ? (CONVA ? (const char*)g.A + ((long)((nxt.pm / 33) * 8192 + 252 * (nxt.pm % 33) - 1)) * (long)(K * 2) : (const char*)g.A + (size_t)nxt.pm * tstep) : cA; const char* nB = has_next ? (const char*)g.Bt + (size_t)nxt.pn * tstep : cB;
        for (int t = 0; t < nt; t += 2) {
            const bool last = (t == nt - 2);
            const char* a1 = cA + (size_t)(t + 1) * kstep;
            const char* a2 = last ? nA : cA + (size_t)(t + 2) * kstep; const char* b2 = last ? nB : cB + (size_t)(t + 2) * kstep;
            const char* a3 = a2 + kstep; const char* b3 = b2 + kstep;
            if (last && has_next) S.a_ready(nxt);
            if constexpr (SP2) {
            PG8_LDB(B0, 0, 0); PG8_LDB(B1, 0, 1); PG8_SCHED; PG8_LDA(At, 0, 0); PG8_STAGE(PG8_SA(1, 1), a1 + hstepA, voffA);
            PG8_WAIT_V(8); PG8_WAIT_L(0); PG8_BAR; PG8_MMA(0, 0, At, B0); PG8_MMA(0, 1, At, B1); PG8_BAR; PG8_SCHED;
            PG8_LDA(At, 0, 1); PG8_STAGE(PG8_SB(0, 0), b2, voffB); PG8_STAGE(PG8_SB(0, 1), b2 + hstep, voffB); PG8_STAGE(PG8_SA(0, 0), a2, voffA);
            PG8_WAIT_V(8); PG8_WAIT_L(0); PG8_BAR; PG8_MMA(1, 0, At, B0); PG8_MMA(1, 1, At, B1); PG8_BAR; PG8_SCHED;
            PG8_LDB(B0, 1, 0); PG8_LDB(B1, 1, 1); PG8_SCHED; PG8_LDA(At, 1, 0); PG8_STAGE(PG8_SA(0, 1), a2 + hstepA, voffA);
            PG8_WAIT_V(8); PG8_WAIT_L(0); PG8_BAR; PG8_MMA(0, 0, At, B0); PG8_MMA(0, 1, At, B1); PG8_BAR; PG8_SCHED;
            PG8_LDA(At, 1, 1); PG8_STAGE(PG8_SB(1, 0), b3, voffB); PG8_STAGE(PG8_SB(1, 1), b3 + hstep, voffB); PG8_STAGE(PG8_SA(1, 0), a3, voffA);
            PG8_WAIT_V(8); PG8_WAIT_L(0); PG8_BAR; PG8_MMA(1, 0, At, B0); PG8_MMA(1, 1, At, B1); PG8_BAR; PG8_SCHED;
            } else {
            PG8_LDB(B0, 0, 0); PG8_SCHED; PG8_LDA(At, 0, 0); PG8_STAGE(PG8_SA(1, 1), a1 + hstepA, voffA);
            PG8_WAIT_L(8); PG8_BAR; PG8_WAIT_L(0); PG8_MMA(0, 0, At, B0); PG8_BAR; PG8_SCHED;
            PG8_LDB(B1, 0, 1); PG8_STAGE(PG8_SB(0, 0), b2, voffB);
            PG8_BAR; PG8_WAIT_L(0); PG8_MMA(0, 1, At, B1); PG8_BAR;
            PG8_LDA(At, 0, 1); PG8_STAGE(PG8_SA(0, 0), a2, voffA);
            PG8_BAR; PG8_WAIT_L(0); PG8_MMA(1, 0, At, B0); PG8_BAR; PG8_SCHED;
            PG8_STAGE(PG8_SB(0, 1), b2 + hstep, voffB);
            PG8_WAIT_V(6); PG8_BAR; PG8_MMA(1, 1, At, B1); PG8_BAR;
            PG8_LDB(B0, 1, 0); PG8_SCHED; PG8_LDA(At, 1, 0); PG8_STAGE(PG8_SA(0, 1), a2 + hstepA, voffA);
            PG8_WAIT_L(8); PG8_BAR; PG8_WAIT_L(0); PG8_MMA(0, 0, At, B0); PG8_BAR; PG8_SCHED;
            PG8_LDB(B1, 1, 1); PG8_STAGE(PG8_SB(1, 0), b3, voffB);
            PG8_BAR; PG8_WAIT_L(0); PG8_MMA(0, 1, At, B1); PG8_BAR;
            PG8_LDA(At, 1, 1); PG8_STAGE(PG8_SA(1, 0), a3, voffA);
            PG8_BAR; PG8_WAIT_L(0); PG8_MMA(1, 0, At, B0); PG8_BAR; PG8_SCHED;
            PG8_STAGE(PG8_SB(1, 1), b3 + hstep, voffB);
            PG8_WAIT_V(6); PG8_BAR; PG8_MMA(1, 1, At, B1); PG8_BAR;
            }
        }
        if constexpr (ALIGN_EPI) { if (wr == 0) PG8_BAR; }
        if constexpr (!Epi::AFTER_DRAIN) { E(acc, cur, wr, wc, fr, fq); S.done(cur); }
        if (!has_next) break;
#pragma unroll
        for (int a = 0; a < 2; ++a)
#pragma unroll
            for (int b = 0; b < 2; ++b)
#pragma unroll
                for (int m = 0; m < 4; ++m)
#pragma unroll
                    for (int n = 0; n < 2; ++n) acc[a][b][m][n] = (f32x4){0.f, 0.f, 0.f, 0.f};
        cur = nxt; cA = nA; cB = nB; ++ui;
        if constexpr (ALIGN_EPI) { if (wr == 1) PG8_BAR; }
    }
    PG8_WAIT_V(0);
    if constexpr (!ALIGN_EPI) { if (wr == 0) PG8_BAR; }
    PG8_BAR;
    if constexpr (Epi::AFTER_DRAIN) { E.fused(acc, cur, wr, wc, fr, fq, lds, wid, lane); S.done(cur); }
#undef PG8_SA
#undef PG8_SB
#undef PG8_STAGE
#undef PG8_LDA
#undef PG8_LDB
#undef PG8_MMA
#undef PG8_WAIT_V
#undef PG8_WAIT_L
#undef PG8_BAR
#undef PG8_SCHED
}
}

using namespace pg8;
#define LAS __attribute__((address_space(3)))
typedef unsigned u32x2 __attribute__((ext_vector_type(2)));
constexpr int MTOK = 32768, DM = 1024, SEQ = 8192, NLAYER = 4;
constexpr float ALPHA = 1.681792830507429f;
constexpr float LN_EPS = 1e-5f, GN_EPS = 1e-6f;
constexpr size_t MiB = 1u << 20;
constexpr size_t WS_COS = 1 * MiB, WS_SIN = 3 * MiB, WS_W = 6 * MiB, WS_XB = 44 * MiB, WS_QNA = 108 * MiB, WS_KNA = 140 * MiB, WS_VTNA = 172 * MiB,
                 WS_KT = 204 * MiB, WS_QR = 268 * MiB, WS_KR = 300 * MiB, WS_VTR = 332 * MiB, WS_GR = 396 * MiB, WS_ST = 460 * MiB, WS_PB = 524 * MiB,
                 WS_GA = 140 * MiB, WS_GB = 204 * MiB, WS_MRG = 268 * MiB, WS_SG = 108 * MiB, WS_H = 172 * MiB, WS_U = 364 * MiB, WS_END = 540 * MiB;
constexpr size_t W_IN = 0, W_A = W_IN + (size_t)6656 * 1024, W_B = W_A + (size_t)1024 * 512, W_O = W_B + (size_t)1024 * 1024, W_UP = W_O + (size_t)1024 * 1024,
                 W_D1 = W_UP + (size_t)5632 * 1024, W_D2 = W_D1 + (size_t)1024 * 1536, W_PG = W_D2 + (size_t)1024 * 1280, W_PP = W_PG + (size_t)1024 * 1024, W_TOTAL = W_PP + (size_t)1024 * 256;
static_assert(W_TOTAL * 2 <= 38 * MiB, "weights fit");
constexpr int FF1 = 1536, FF2 = 1280;

__device__ __forceinline__ float bflo(unsigned w) { return __uint_as_float(w << 16); }
__device__ __forceinline__ float bfhi(unsigned w) { return __uint_as_float(w & 0xffff0000u); }
__device__ __forceinline__ float sigm(float x) { return 1.f / (1.f + __expf(-x)); }
__device__ __forceinline__ float gelu_tanh(float x) { const float y2 = 1.5957691216057308f * (x + 0.044715f * x * x * x); return x / (1.f + __expf(-y2)); }
__device__ __forceinline__ bf16x8 mk8(unsigned a, unsigned b, unsigned c, unsigned d) { u32x4 w = {a, b, c, d}; return __builtin_bit_cast(bf16x8, w); }
__device__ __forceinline__ bf16x8 scale8(bf16x8 v, float s) { u32x4 w = __builtin_bit_cast(u32x4, v);
    return mk8(cvt_pk_bf16(bflo(w.x) * s, bfhi(w.x) * s), cvt_pk_bf16(bflo(w.y) * s, bfhi(w.y) * s), cvt_pk_bf16(bflo(w.z) * s, bfhi(w.z) * s), cvt_pk_bf16(bflo(w.w) * s, bfhi(w.w) * s)); }
#define MFMA16(a, b, c) __builtin_amdgcn_mfma_f32_16x16x32_bf16((a), (b), (c), 0, 0, 0)

template <int ACT> struct EpiBf {
    static constexpr bool PERM = true, AFTER_DRAIN = false;
    bf16_t* base0; bf16_t* base1; int nsplit; int ld;
    __device__ __forceinline__ void operator()(const f32x4 (&acc)[2][2][4][2], const Unit& u, int wr, int wc, int fr, int fq) const {
        asm volatile("" : "+v"(fr), "+v"(fq));
        bf16_t* base = (u.pn < nsplit) ? base0 + u.pn * 256 : base1 + (u.pn - nsplit) * 256;
        const int row0 = u.pm * 256 + wr * 64 + fr, col0 = wc * 32 + 8 * fq;
#pragma unroll
        for (int ai = 0; ai < 2; ++ai)
#pragma unroll
            for (int m = 0; m < 4; ++m) { bf16_t* rowp = base + (size_t)(row0 + ai * HALF + m * 16) * ld + col0;
#pragma unroll
                for (int bj = 0; bj < 2; ++bj) { f32x4 v0 = acc[ai][bj][m][0], v1 = acc[ai][bj][m][1];
                    if (ACT == 2) { v0 = (f32x4){sigm(v0[0]), sigm(v0[1]), sigm(v0[2]), sigm(v0[3])}; v1 = (f32x4){sigm(v1[0]), sigm(v1[1]), sigm(v1[2]), sigm(v1[3])}; }
                    u32x4 w; w.x = cvt_pk_bf16(v0[0], v0[1]); w.y = cvt_pk_bf16(v0[2], v0[3]); w.z = cvt_pk_bf16(v1[0], v1[1]); w.w = cvt_pk_bf16(v1[2], v1[3]);
                    *(u32x4*)(rowp + bj * HALF) = w; } }
    }
};
struct EpiVT {
    static constexpr bool PERM = true, AFTER_DRAIN = false;
    bf16_t* vtna; bf16_t* vtr;
    __device__ __forceinline__ void operator()(const f32x4 (&acc)[2][2][4][2], const Unit& u, int wr, int wc, int fr, int fq) const {
        asm volatile("" : "+v"(fr), "+v"(fq));
        bf16_t* base = (u.pm < 2) ? vtna + (size_t)(u.pm * 256) * MTOK : vtr + (size_t)((u.pm - 2) * 256) * MTOK;
        const int row0 = wr * 64 + fr, col0 = u.pn * 256 + wc * 32 + 8 * fq;
#pragma unroll
        for (int ai = 0; ai < 2; ++ai)
#pragma unroll
            for (int m = 0; m < 4; ++m) { bf16_t* rowp = base + (size_t)(row0 + ai * HALF + m * 16) * MTOK + col0;
#pragma unroll
                for (int bj = 0; bj < 2; ++bj) { const f32x4 v0 = acc[ai][bj][m][0], v1 = acc[ai][bj][m][1];
                    u32x4 w; w.x = cvt_pk_bf16(v0[0], v0[1]); w.y = cvt_pk_bf16(v0[2], v0[3]); w.z = cvt_pk_bf16(v1[0], v1[1]); w.w = cvt_pk_bf16(v1[2], v1[3]);
                    *(u32x4*)(rowp + bj * HALF) = w; } }
    }
};
struct EpiProj {
    static constexpr bool PERM = true, AFTER_DRAIN = false;
    bf16_t *qna, *kna, *qr, *kr, *kt, *gr; const float* cosT; const float* sinT;
    __device__ __forceinline__ void operator()(const f32x4 (&acc)[2][2][4][2], const Unit& u, int wr, int wc, int fr, int fq) const {
        asm volatile("" : "+v"(fr), "+v"(fq));
        const int pn = u.pn, row0 = u.pm * 256 + wr * 64 + fr;
        if (pn < 4 || pn >= 8) {
            bf16_t* base; int ld; float sc = 1.f;
            if (pn < 2) { base = qna + pn * 256; ld = 512; sc = 0.125f; } else if (pn < 4) { base = kna + (pn - 2) * 256; ld = 512; } else { base = gr + (pn - 8) * 256; ld = 1024; }
            const int col0 = wc * 32 + 8 * fq;
#pragma unroll
            for (int ai = 0; ai < 2; ++ai)
#pragma unroll
                for (int m = 0; m < 4; ++m) { bf16_t* rowp = base + (size_t)(row0 + ai * HALF + m * 16) * ld + col0;
#pragma unroll
                    for (int bj = 0; bj < 2; ++bj) { const f32x4 v0 = acc[ai][bj][m][0] * sc, v1 = acc[ai][bj][m][1] * sc;
                        u32x4 w; w.x = cvt_pk_bf16(v0[0], v0[1]); w.y = cvt_pk_bf16(v0[2], v0[3]); w.z = cvt_pk_bf16(v1[0], v1[1]); w.w = cvt_pk_bf16(v1[2], v1[3]);
                        *(u32x4*)(rowp + bj * HALF) = w; } }
        } else {
            const bool isk = pn >= 6; bf16_t* base = isk ? kr : qr; const int hb = (isk ? pn - 6 : pn - 4) * 2;
            const float sc = isk ? 0.08838834764831845f : 1.f;
            const int i4 = 4 * (4 * wc + fq);
#pragma unroll
            for (int ai = 0; ai < 2; ++ai)
#pragma unroll
                for (int m = 0; m < 4; ++m) { const int row = row0 + ai * HALF + m * 16, t = row & (SEQ - 1);
                    const f32x4 c = *(const f32x4*)(cosT + t * 64 + i4), s = *(const f32x4*)(sinT + t * 64 + i4);
#pragma unroll
                    for (int bj = 0; bj < 2; ++bj) { const int head = hb + bj; const f32x4 x1 = acc[ai][bj][m][0], x2 = acc[ai][bj][m][1];
                        const f32x4 o1 = (x1 * c - x2 * s) * sc, o2 = (x2 * c + x1 * s) * sc;
                        u32x2 w1, w2; w1.x = cvt_pk_bf16(o1[0], o1[1]); w1.y = cvt_pk_bf16(o1[2], o1[3]); w2.x = cvt_pk_bf16(o2[0], o2[1]); w2.y = cvt_pk_bf16(o2[2], o2[3]);
                        bf16_t* p = base + (size_t)row * 512 + head * 128 + i4;
                        *(u32x2*)p = w1; *(u32x2*)(p + 64) = w2;
                        if (isk) { bf16_t* q = kt + (size_t)(head * 128 + i4) * MTOK + row;
                            q[0] = (bf16_t)(w1.x & 0xffffu); q[(size_t)MTOK] = (bf16_t)(w1.x >> 16); q[(size_t)2 * MTOK] = (bf16_t)(w1.y & 0xffffu); q[(size_t)3 * MTOK] = (bf16_t)(w1.y >> 16);
                            bf16_t* q2 = q + (size_t)64 * MTOK;
                            q2[0] = (bf16_t)(w2.x & 0xffffu); q2[(size_t)MTOK] = (bf16_t)(w2.x >> 16); q2[(size_t)2 * MTOK] = (bf16_t)(w2.y & 0xffffu); q2[(size_t)3 * MTOK] = (bf16_t)(w2.y >> 16); } } }
        }
    }
};
template <int MODE> struct EpiMerge {
    static constexpr bool PERM = true, AFTER_DRAIN = false;
    bf16_t* mrg; const bf16_t* gate;
    __device__ __forceinline__ void operator()(const f32x4 (&acc)[2][2][4][2], const Unit& u, int wr, int wc, int fr, int fq) const {
        asm volatile("" : "+v"(fr), "+v"(fq));
        const int row0 = u.pm * 256 + wr * 64 + fr, col0 = u.pn * 256 + wc * 32 + 8 * fq;
#pragma unroll
        for (int ai = 0; ai < 2; ++ai)
#pragma unroll
            for (int m = 0; m < 4; ++m) { const size_t off = (size_t)(row0 + ai * HALF + m * 16) * 1024 + col0;
#pragma unroll
                for (int bj = 0; bj < 2; ++bj) { const f32x4 v0 = acc[ai][bj][m][0], v1 = acc[ai][bj][m][1];
                    const u32x4 g = *(const u32x4*)(gate + off + bj * HALF);
                    float r0 = bflo(g.x) * v0[0], r1 = bfhi(g.x) * v0[1], r2 = bflo(g.y) * v0[2], r3 = bfhi(g.y) * v0[3], r4 = bflo(g.z) * v1[0], r5 = bfhi(g.z) * v1[1], r6 = bflo(g.w) * v1[2], r7 = bfhi(g.w) * v1[3];
                    if (MODE == 1) { const u32x4 p = *(const u32x4*)(mrg + off + bj * HALF);
                        r0 += bflo(p.x); r1 += bfhi(p.x); r2 += bflo(p.y); r3 += bfhi(p.y); r4 += bflo(p.z); r5 += bfhi(p.z); r6 += bflo(p.w); r7 += bfhi(p.w); }
                    u32x4 w; w.x = cvt_pk_bf16(r0, r1); w.y = cvt_pk_bf16(r2, r3); w.z = cvt_pk_bf16(r4, r5); w.w = cvt_pk_bf16(r6, r7);
                    *(u32x4*)(mrg + off + bj * HALF) = w; } }
    }
};
template <int MODE> struct EpiF32 {
    static constexpr bool PERM = false, AFTER_DRAIN = false;
    float* out; const float* res; const bf16_t* sg; const bf16_t* pp;
    __device__ __forceinline__ void operator()(const f32x4 (&acc)[2][2][4][2], const Unit& u, int wr, int wc, int fr, int fq) const {
        asm volatile("" : "+v"(fr), "+v"(fq));
        const int row0 = u.pm * 256 + wr * 64 + fr, col0 = u.pn * 256 + wc * 32 + 4 * fq;
#pragma unroll
        for (int ai = 0; ai < 2; ++ai)
#pragma unroll
            for (int m = 0; m < 4; ++m) { const size_t off = (size_t)(row0 + ai * HALF + m * 16) * 1024 + col0;
#pragma unroll
                for (int bj = 0; bj < 2; ++bj)
#pragma unroll
                    for (int n = 0; n < 2; ++n) { const size_t o = off + bj * HALF + n * 16; const f32x4 a = acc[ai][bj][m][n]; f32x4 r;
                        if (MODE == 0) { r = *(const f32x4*)(res + o) * ALPHA + a; }
                        else if (MODE == 1) { const u32x2 g = *(const u32x2*)(sg + o); const f32x4 gv = {bflo(g.x), bfhi(g.x), bflo(g.y), bfhi(g.y)}; r = *(const f32x4*)(out + o) * ALPHA + gv * a; }
                        else if (MODE == 3) { const u32x2 g = *(const u32x2*)(sg + o), p = *(const u32x2*)(pp + o); const f32x4 gv = {bflo(g.x), bfhi(g.x), bflo(g.y), bfhi(g.y)}, pv = {bflo(p.x), bfhi(p.x), bflo(p.y), bfhi(p.y)};
                            r = *(const f32x4*)(out + o) * ALPHA + gv * pv + a; }
                        else { r = *(const f32x4*)(out + o) + a; }
                        *(f32x4*)(out + o) = r; } }
    }
};

struct EpiConv {
    static constexpr bool PERM = true, AFTER_DRAIN = false;
    bf16_t* U; const float* cw; const float* cb;
    __device__ __forceinline__ void operator()(const f32x4 (&acc)[2][2][4][2], const Unit& u, int wr, int wc, int fr, int fq) const {
        asm volatile("" : "+v"(fr), "+v"(fq));
        const int bb = u.pm / 33, kt = u.pm - 33 * bb, tb = bb * SEQ;
        const int t0 = tb + 252 * kt + 126 * wr - 1 + 8 * fr;
#pragma unroll
        for (int bj = 0; bj < 2; ++bj) {
            const int j = u.pn * 128 + 64 * bj + 16 * wc + 4 * fq;
            const f32x4 wa0 = *(const f32x4*)(cw + j), wa1 = *(const f32x4*)(cw + 5632 + j), wa2 = *(const f32x4*)(cw + 2 * 5632 + j), ba = *(const f32x4*)(cb + j);
            const f32x4 wb0 = *(const f32x4*)(cw + 2816 + j), wb1 = *(const f32x4*)(cw + 5632 + 2816 + j), wb2 = *(const f32x4*)(cw + 2 * 5632 + 2816 + j), bbv = *(const f32x4*)(cb + 2816 + j);
            const f32x4 z4 = {0.f, 0.f, 0.f, 0.f};
#define HIN(q) ((t0 + (q) >= tb) && (t0 + (q) < tb + SEQ))
#define HA(q) (HIN(q) ? acc[(q) >> 2][bj][(q) & 3][0] : z4)
#define HB(q) (HIN(q) ? acc[(q) >> 2][bj][(q) & 3][1] : z4)
            f32x4 pa, pb, na, nb;
            { const f32x4 a7 = HA(7), b7 = HB(7), a0 = HA(0), b0 = HB(0);
#pragma unroll
              for (int e = 0; e < 4; ++e) { pa[e] = __shfl_up(a7[e], 1, 16); pb[e] = __shfl_up(b7[e], 1, 16); na[e] = __shfl_down(a0[e], 1, 16); nb[e] = __shfl_down(b0[e], 1, 16); } }
#pragma unroll
            for (int q = 0; q < 8; ++q) {
                const f32x4 xa = (q == 0) ? pa : HA(q == 0 ? 0 : q - 1), ya = (q == 7) ? na : HA(q == 7 ? 7 : q + 1), ma = HA(q);
                const f32x4 xb = (q == 0) ? pb : HB(q == 0 ? 0 : q - 1), yb = (q == 7) ? nb : HB(q == 7 ? 7 : q + 1), mb = HB(q);
                const f32x4 ca = wa0 * xa + wa1 * ma + wa2 * ya + ba, cbv = wb0 * xb + wb1 * mb + wb2 * yb + bbv;
                const int t = t0 + q;
                const bool ok = !(fr == 0 && q == 0) && !(fr == 15 && q == 7) && (t < tb + SEQ);
                if (ok) { u32x2 w; w.x = cvt_pk_bf16(gelu_tanh(ca[0]) * cbv[0], gelu_tanh(ca[1]) * cbv[1]); w.y = cvt_pk_bf16(gelu_tanh(ca[2]) * cbv[2], gelu_tanh(ca[3]) * cbv[3]);
                    *(u32x2*)(U + (size_t)t * 2816 + j) = w; }
            }
#undef HIN
#undef HA
#undef HB
        }
    }
};

__device__ __forceinline__ float wave_sum(float v) {
#pragma unroll
    for (int o = 1; o < 64; o <<= 1) v += __shfl_xor(v, o);
    return v;
}
__device__ __forceinline__ int rotp(int x) { const int head = x >> 7, d = x & 127, i = (d & 63) >> 2, e = d & 3; return head * 128 + 8 * i + ((d >> 6) << 2) + e; }
__device__ __forceinline__ int map_win(int n) {
    if (n < 1024) return n;
    if (n < 1536) return 3072 + (n - 1024);
    if (n < 2048) return 1024 + rotp(n - 1536);
    if (n < 2560) return 1536 + rotp(n - 2048);
    if (n < 3584) return 3584 + (n - 2560);
    if (n < 4608) return 2048 + (n - 3584);
    return n;
}
__device__ __forceinline__ int map_wup(int n) {
    const bool a = n < 2816; const int j = a ? n : n - 2816; const int r = j & 127;
    return 256 * (j >> 7) + 8 * (r >> 2) + (r & 3) + (a ? 0 : 4);
}
template <int MAP> __device__ __forceinline__ void transpose_item(const float* W, int N, int k0, int n0, bf16_t* dst, int dstK, int kbase, LAS float* scr, int lane) {
#pragma unroll 8
    for (int i = 0; i < 32; ++i) { const int kk = 2 * i + (lane >> 5); scr[kk * 33 + (lane & 31)] = W[(size_t)(k0 + kk) * N + n0 + (lane & 31)]; }
    asm volatile("s_waitcnt lgkmcnt(0)" ::: "memory");
    const int c = lane & 7;
#pragma unroll
    for (int j = 0; j < 4; ++j) { const int n = (lane >> 3) + 8 * j; const LAS float* s = scr + (8 * c) * 33 + n;
        u32x4 o; o.x = cvt_pk_bf16(s[0 * 33], s[1 * 33]); o.y = cvt_pk_bf16(s[2 * 33], s[3 * 33]); o.z = cvt_pk_bf16(s[4 * 33], s[5 * 33]); o.w = cvt_pk_bf16(s[6 * 33], s[7 * 33]);
        const int sn = n0 + n; const int dr = (MAP == 1) ? map_win(sn) : (MAP == 2) ? map_wup(sn) : sn;
        *(u32x4*)(dst + (size_t)dr * dstK + (k0 - kbase) + 8 * c) = o; }
    asm volatile("s_waitcnt lgkmcnt(0)" ::: "memory");
}
struct In { const float* p[19]; };
__device__ __forceinline__ void convert_layer(const In& in, int layer, bf16_t* Wb, bf16_t* PB, LAS float* scr, int gw, int NGW, int lane) {
    const float* w_in = in.p[2] + (size_t)layer * 1024 * 6656; const float* w_a = in.p[6] + (size_t)layer * 512 * 1024; const float* w_b = in.p[7] + (size_t)layer * 1024 * 1024;
    const float* w_o = in.p[8] + (size_t)layer * 1024 * 1024; const float* w_up = in.p[11] + (size_t)layer * 1024 * 5632; const float* w_dn = in.p[14] + (size_t)layer * 2816 * 1024;
    const float* w_pg = in.p[15] + (size_t)layer * 1024 * 1024; const float* w_pp = in.p[16] + (size_t)layer * 256 * 1024;
    constexpr int I_IN = 16 * 208, I_A = 8 * 32, I_B = 16 * 32, I_O = 16 * 32, I_UP = 16 * 176, I_D1 = 24 * 32, I_D2 = 20 * 32, I_PG = 16 * 32, I_PP = 4 * 32;
    constexpr int NIT = I_IN + I_A + I_B + I_O + I_UP + I_D1 + I_D2 + I_PG + I_PP;
    for (int it = gw; it < NIT; it += NGW) {
        int r = it;
        if (r < I_IN) { transpose_item<1>(w_in, 6656, 64 * (r / 208), 32 * (r % 208), Wb + W_IN, 1024, 0, scr, lane); continue; } r -= I_IN;
        if (r < I_A) { transpose_item<0>(w_a, 1024, 64 * (r / 32), 32 * (r % 32), Wb + W_A, 512, 0, scr, lane); continue; } r -= I_A;
        if (r < I_B) { transpose_item<0>(w_b, 1024, 64 * (r / 32), 32 * (r % 32), Wb + W_B, 1024, 0, scr, lane); continue; } r -= I_B;
        if (r < I_O) { transpose_item<0>(w_o, 1024, 64 * (r / 32), 32 * (r % 32), Wb + W_O, 1024, 0, scr, lane); continue; } r -= I_O;
        if (r < I_UP) { transpose_item<2>(w_up, 5632, 64 * (r / 176), 32 * (r % 176), Wb + W_UP, 1024, 0, scr, lane); continue; } r -= I_UP;
        if (r < I_D1 + I_D2) { transpose_item<0>(w_dn, 1024, 64 * (r / 32), 32 * (r % 32), Wb + W_D1, 2816, 0, scr, lane); continue; } r -= I_D1 + I_D2;
        if (r < I_PG) { transpose_item<0>(w_pg, 1024, 64 * (r / 32), 32 * (r % 32), Wb + W_PG, 1024, 0, scr, lane); continue; } r -= I_PG;
        transpose_item<0>(w_pp, 1024, 64 * (r / 32), 32 * (r % 32), Wb + W_PP, 256, 0, scr, lane);
    }
    const float* ps = in.p[1] + (size_t)layer * MTOK * 256;
    for (int i = gw; i < MTOK * 256 / 512; i += NGW) { const size_t e = (size_t)i * 512 + lane * 8; const f32x4 a = *(const f32x4*)(ps + e), b = *(const f32x4*)(ps + e + 4);
        u32x4 w; w.x = cvt_pk_bf16(a[0], a[1]); w.y = cvt_pk_bf16(a[2], a[3]); w.z = cvt_pk_bf16(b[0], b[1]); w.w = cvt_pk_bf16(b[2], b[3]); *(u32x4*)(PB + e) = w; }
}
__device__ __forceinline__ void ln_row(const float* src, float* dst, bf16_t* xb, const float* g, const float* b, int lane) {
    const f32x4* xr = (const f32x4*)src + lane; f32x4 v[4]; float s = 0.f;
#pragma unroll
    for (int j = 0; j < 4; ++j) { v[j] = xr[64 * j]; s += (v[j][0] + v[j][1]) + (v[j][2] + v[j][3]); }
    const float mean = wave_sum(s) * (1.f / DM); float s2 = 0.f;
#pragma unroll
    for (int j = 0; j < 4; ++j) { v[j] = v[j] - mean; s2 += (v[j][0] * v[j][0] + v[j][1] * v[j][1]) + (v[j][2] * v[j][2] + v[j][3] * v[j][3]); }
    const float rstd = 1.f / sqrtf(wave_sum(s2) * (1.f / DM) + LN_EPS);
#pragma unroll
    for (int j = 0; j < 4; ++j) { const f32x4 gg = ((const f32x4*)g)[lane + 64 * j], bb = ((const f32x4*)b)[lane + 64 * j]; const f32x4 o = v[j] * rstd * gg + bb;
        ((f32x4*)dst)[lane + 64 * j] = o; u32x2 w; w.x = cvt_pk_bf16(o[0], o[1]); w.y = cvt_pk_bf16(o[2], o[3]); ((u32x2*)xb)[lane + 64 * j] = w; }
}

__device__ __forceinline__ void na_phase(bf16_t* QNA, const bf16_t* KNA, const bf16_t* VT, const float* rpb, LAS unsigned char* ldsb, int tid, int wave, int lane, int bid) {
    const int fr = lane & 15, fq = lane >> 4, hd = wave >> 2, j = wave & 3;
    LAS float* rpbL = (LAS float*)(ldsb + 135168);
    u32x4 stg[16];
#define NA_ISSUE_K(unit_) do { const int hp_ = (unit_) & 3, r_ = ((unit_) >> 2) & 127, b_ = (unit_) >> 9; const int rs_ = min(max(r_ - 4, 0), 120); \
        const bf16_t* kb_ = KNA + (size_t)(b_ * SEQ + rs_ * 64) * 512 + hp_ * 128; \
        _Pragma("unroll") for (int i = 0; i < 16; ++i) { const int idx = i * 512 + tid; stg[i] = *(const u32x4*)(kb_ + (size_t)(idx >> 4) * 512 + (idx & 15) * 8); } } while (0)
    if (bid < 2048) NA_ISSUE_K(bid);
    for (int unit = bid; unit < 2048; unit += gridDim.x) {
        const int hp = unit & 3, r = (unit >> 2) & 127, b = unit >> 9, h = 2 * hp + hd;
        const int tq = b * SEQ + r * 64 + 16 * j;
        const int rs = min(max(r - 4, 0), 120), c0 = min(max(16 * j - 8, 0), 32);
        const int qcol = 16 * j + fr, cs = min(max(qcol - 8, 0), 48);
        bf16_t* qp = QNA + (size_t)(tq + fr) * 512 + h * 64;
        const bf16x8 qf0 = *(const bf16x8*)(qp + 8 * fq), qf1 = *(const bf16x8*)(qp + 32 + 8 * fq);
        for (int i = tid; i < 930; i += 512) rpbL[i] = rpb[hp * 930 + i];
        { LAS unsigned char* kw_ = ldsb + ((tid & 15) >> 3) * 65536 + (tid >> 4) * 128 + (((tid & 7) ^ ((tid >> 5) & 7)) * 16);
#pragma unroll
          for (int i = 0; i < 16; ++i) *(LAS u32x4*)(kw_ + i * 4096) = stg[i]; }
        __syncthreads();
        { const bf16_t* vb_ = VT + (size_t)(hp * 128) * MTOK + (size_t)b * SEQ + rs * 64;
#pragma unroll
          for (int i = 0; i < 8; ++i) { const int idx = i * 512 + tid; stg[i] = *(const u32x4*)(vb_ + (size_t)(idx >> 6) * MTOK + ((idx >> 3) & 7) * 64 + (idx & 7) * 8); } }
        f32x4 s[16]; float mx = -INFINITY;
#pragma unroll
        for (int a = 0; a < 16; ++a) { const int kr = a >> 1;
            const int col = c0 + 8 * (fr >> 2) + 4 * (a & 1) + (fr & 3);
            const LAS unsigned char* kp = ldsb + (hd * 512 + kr * 64 + col) * 128; const int sw = (col >> 1) & 7;
            const bf16x8 kf0 = *(const LAS bf16x8*)(kp + ((fq ^ sw) * 16)), kf1 = *(const LAS bf16x8*)(kp + (((4 + fq) ^ sw) * 16));
            f32x4 acc = {0.f, 0.f, 0.f, 0.f}; acc = MFMA16(kf0, qf0, acc); acc = MFMA16(kf1, qf1, acc);
            const LAS float* bp = rpbL + hd * 465 + (rs + kr - r + 7) * 31;
#pragma unroll
            for (int v = 0; v < 4; ++v) { const int kcol = c0 + 8 * fq + 4 * (a & 1) + v; const bool valid = (kcol >= cs) && (kcol < cs + 16);
                const int bi = min(max(kcol - qcol + 15, 0), 30);
                const float sv = valid ? acc[v] + bp[bi] : -INFINITY; s[a][v] = sv; mx = fmaxf(mx, sv); }
            if ((a & 3) == 3) __builtin_amdgcn_sched_barrier(0); }
        mx = fmaxf(mx, __shfl_xor(mx, 16)); mx = fmaxf(mx, __shfl_xor(mx, 32));
        float l = 0.f;
#pragma unroll
        for (int a = 0; a < 16; ++a)
#pragma unroll
            for (int v = 0; v < 4; ++v) { const float p = __expf(s[a][v] - mx); s[a][v] = p; l += p; }
        l += __shfl_xor(l, 16); l += __shfl_xor(l, 32);
        const float rl = 1.f / l;
        bf16x8 pf[8];
#pragma unroll
        for (int ks = 0; ks < 8; ++ks) pf[ks] = mk8(cvt_pk_bf16(s[2 * ks][0], s[2 * ks][1]), cvt_pk_bf16(s[2 * ks][2], s[2 * ks][3]), cvt_pk_bf16(s[2 * ks + 1][0], s[2 * ks + 1][1]), cvt_pk_bf16(s[2 * ks + 1][2], s[2 * ks + 1][3]));
        { const bf16_t* vb_ = VT + (size_t)(hp * 128) * MTOK + (size_t)b * SEQ + rs * 64;
#pragma unroll
          for (int i = 8; i < 16; ++i) { const int idx = i * 512 + tid; stg[i] = *(const u32x4*)(vb_ + (size_t)(idx >> 6) * MTOK + ((idx >> 3) & 7) * 64 + (idx & 7) * 8); } }
        __syncthreads();
        { const int d0_ = tid >> 6, ch_ = (tid & 7) ^ (d0_ >> 1);
          LAS unsigned char* vw_ = ldsb + ((tid >> 3) & 7) * 16384 + d0_ * 128;
#pragma unroll
          for (int i = 0; i < 16; ++i) *(LAS u32x4*)(vw_ + i * 1024 + (((i & 1) ? (ch_ ^ 4) : ch_) * 16)) = stg[i]; }
        __syncthreads();
        if (unit + (int)gridDim.x < 2048) NA_ISSUE_K(unit + (int)gridDim.x);
        f32x4 o[4];
#pragma unroll
        for (int dt = 0; dt < 4; ++dt) o[dt] = (f32x4){0.f, 0.f, 0.f, 0.f};
        const int cch = (c0 >> 3) + fq;
#pragma unroll
        for (int ks = 0; ks < 8; ++ks)
#pragma unroll
            for (int dt = 0; dt < 4; ++dt) { const int dd = hd * 64 + 16 * dt + fr;
                const bf16x8 vf = *(const LAS bf16x8*)(ldsb + (ks * 128 + dd) * 128 + ((cch ^ ((dd >> 1) & 7)) * 16));
                o[dt] = MFMA16(vf, pf[ks], o[dt]); if (dt == 3 && (ks & 1)) __builtin_amdgcn_sched_barrier(0); }
#pragma unroll
        for (int dt = 0; dt < 4; ++dt) { u32x2 w; w.x = cvt_pk_bf16(o[dt][0] * rl, o[dt][1] * rl); w.y = cvt_pk_bf16(o[dt][2] * rl, o[dt][3] * rl);
            *(u32x2*)(qp + 16 * dt + 4 * fq) = w; }
        __syncthreads();
    }
#undef NA_ISSUE_K
}

__device__ __forceinline__ void ret_kv_phase(const bf16_t* KT, const bf16_t* VT, bf16_t* ST, const float* dec_f, const float* dec_b, LAS unsigned char* ldsb, int tid, int wave, int lane, int bid) {
    const int fr = lane & 15, fq = lane >> 4;
    constexpr int VBUF = 20480;
    for (int unit = bid; unit < 512; unit += gridDim.x) {
        const int c = unit & 31, bh = unit >> 5, h = bh & 3, b = bh >> 2;
        const size_t tok0 = (size_t)b * SEQ + c * 256;
        const float lgf = log2f(1.f / (1.f + expf(-dec_f[h]))), lgb = log2f(1.f / (1.f + expf(-dec_b[h])));
        f32x4 af[16], ab[16];
#pragma unroll
        for (int dt = 0; dt < 16; ++dt) { af[dt] = (f32x4){0.f, 0.f, 0.f, 0.f}; ab[dt] = (f32x4){0.f, 0.f, 0.f, 0.f}; }
        const bf16_t* kp = KT + (size_t)(h * 128 + 16 * wave + fr) * MTOK + tok0 + 8 * fq;
        const bf16_t* vg0 = VT + (size_t)(h * 256 + (tid >> 2)) * MTOK + tok0 + 8 * (tid & 3);
        const bf16_t* vg1 = vg0 + (size_t)128 * MTOK;
        const int vl0 = (tid >> 2) * 80 + (tid & 3) * 16, vl1 = vl0 + 128 * 80;
        u32x4 rv0 = *(const u32x4*)vg0, rv1 = *(const u32x4*)vg1;
        __syncthreads();
        *(LAS u32x4*)(ldsb + vl0) = rv0; *(LAS u32x4*)(ldsb + vl1) = rv1;
        __syncthreads();
#pragma unroll 1
        for (int s = 0; s < 8; ++s) {
            LAS unsigned char* cur = ldsb + (s & 1) * VBUF; LAS unsigned char* nxt = ldsb + ((s + 1) & 1) * VBUF;
            if (s < 7) { rv0 = *(const u32x4*)(vg0 + 32 * (s + 1)); rv1 = *(const u32x4*)(vg1 + 32 * (s + 1)); }
            const u32x4 kw = *(const u32x4*)(kp + 32 * s);
            const int j0 = 32 * s + 8 * fq;
            float zf[8], zb[8];
#pragma unroll
            for (int e = 0; e < 8; ++e) { zf[e] = exp2f(lgf * (float)(255 - j0 - e)); zb[e] = exp2f(lgb * (float)(j0 + e)); }
            const bf16x8 kf = mk8(cvt_pk_bf16(bflo(kw.x) * zf[0], bfhi(kw.x) * zf[1]), cvt_pk_bf16(bflo(kw.y) * zf[2], bfhi(kw.y) * zf[3]), cvt_pk_bf16(bflo(kw.z) * zf[4], bfhi(kw.z) * zf[5]), cvt_pk_bf16(bflo(kw.w) * zf[6], bfhi(kw.w) * zf[7]));
            const bf16x8 kb = mk8(cvt_pk_bf16(bflo(kw.x) * zb[0], bfhi(kw.x) * zb[1]), cvt_pk_bf16(bflo(kw.y) * zb[2], bfhi(kw.y) * zb[3]), cvt_pk_bf16(bflo(kw.z) * zb[4], bfhi(kw.z) * zb[5]), cvt_pk_bf16(bflo(kw.w) * zb[6], bfhi(kw.w) * zb[7]));
            const LAS unsigned char* vp = cur + fr * 80 + 16 * fq;
#pragma unroll
            for (int dt = 0; dt < 16; ++dt) { const bf16x8 vf = *(const LAS bf16x8*)(vp + dt * 1280);
                af[dt] = MFMA16(kf, vf, af[dt]); ab[dt] = MFMA16(kb, vf, ab[dt]); }
            if (s < 7) { *(LAS u32x4*)(nxt + vl0) = rv0; *(LAS u32x4*)(nxt + vl1) = rv1; }
            __syncthreads();
        }
        bf16_t* sf = ST + ((size_t)(bh * 32 + c) * 2) * 32768 + 16 * wave + 4 * fq;
#pragma unroll
        for (int dt = 0; dt < 16; ++dt) { u32x2 w; w.x = cvt_pk_bf16(af[dt][0], af[dt][1]); w.y = cvt_pk_bf16(af[dt][2], af[dt][3]); *(u32x2*)(sf + (size_t)(16 * dt + fr) * 128) = w;
            u32x2 x; x.x = cvt_pk_bf16(ab[dt][0], ab[dt][1]); x.y = cvt_pk_bf16(ab[dt][2], ab[dt][3]); *(u32x2*)(sf + 32768 + (size_t)(16 * dt + fr) * 128) = x; }
    }
    __syncthreads();
}
__device__ __forceinline__ void ret_scan_phase(bf16_t* ST, const float* dec_f, const float* dec_b, int tid, int bid) {
    for (int g = bid * 512 + tid; g < 131072; g += gridDim.x * 512) {
        const int e8 = g & 4095, bhd = g >> 12, dir = bhd & 1, bh = bhd >> 1, h = bh & 3;
        const float lg = log2f(1.f / (1.f + expf(-(dir ? dec_b[h] : dec_f[h])))); const float dec = exp2f(256.f * lg);
        bf16_t* base = ST + ((size_t)(bh * 32) * 2 + dir) * 32768 + (size_t)e8 * 8;
        u32x4 v[32];
#pragma unroll
        for (int it = 0; it < 32; ++it) { const int c = dir ? 31 - it : it; v[it] = *(const u32x4*)(base + (size_t)c * 65536); }
        float S[8];
#pragma unroll
        for (int e = 0; e < 8; ++e) S[e] = 0.f;
#pragma unroll
        for (int it = 0; it < 32; ++it) { const int c = dir ? 31 - it : it;
            u32x4 w; w.x = cvt_pk_bf16(S[0], S[1]); w.y = cvt_pk_bf16(S[2], S[3]); w.z = cvt_pk_bf16(S[4], S[5]); w.w = cvt_pk_bf16(S[6], S[7]);
            *(u32x4*)(base + (size_t)c * 65536) = w;
            S[0] = S[0] * dec + bflo(v[it].x); S[1] = S[1] * dec + bfhi(v[it].x); S[2] = S[2] * dec + bflo(v[it].y); S[3] = S[3] * dec + bfhi(v[it].y);
            S[4] = S[4] * dec + bflo(v[it].z); S[5] = S[5] * dec + bfhi(v[it].z); S[6] = S[6] * dec + bflo(v[it].w); S[7] = S[7] * dec + bfhi(v[it].w); }
    }
}
__device__ __forceinline__ void ret_out_phase(const bf16_t* QR, const bf16_t* KR, const bf16_t* VT, const bf16_t* ST, bf16_t* GR, const float* dec_f, const float* dec_b, LAS unsigned char* ldsb, int tid, int wave, int lane, int bid) {
    const int fr = lane & 15, fq = lane >> 4;
    constexpr int KSL = 8704, SBUF = 29184, SOFF = 65536;
    for (int unit = bid; unit < 512; unit += gridDim.x) {
        const int c = unit & 31, bh = unit >> 5, h = bh & 3, b = bh >> 2;
        const size_t tok0 = (size_t)b * SEQ + c * 256;
        const float lgf = log2f(1.f / (1.f + expf(-dec_f[h]))), lgb = log2f(1.f / (1.f + expf(-dec_b[h])));
        LAS bf16x8* qL = (LAS bf16x8*)(ldsb + wave * 8192) + lane;
#pragma unroll
        for (int mi = 0; mi < 2; ++mi)
#pragma unroll
            for (int ks = 0; ks < 4; ++ks) qL[(mi * 4 + ks) * 64] = *(const bf16x8*)(QR + (tok0 + 32 * wave + 16 * mi + fr) * 512 + h * 128 + 32 * ks + 8 * fq);
#define QF(mi, ks) (qL[((mi) * 4 + (ks)) * 64])
        f32x4 acc[16][2];
#pragma unroll
        for (int dt = 0; dt < 16; ++dt) { acc[dt][0] = (f32x4){0.f, 0.f, 0.f, 0.f}; acc[dt][1] = (f32x4){0.f, 0.f, 0.f, 0.f}; }
        const bf16_t* kg = KR + (tok0 + (tid >> 4)) * 512 + h * 128 + (tid & 15) * 8;
        const int kl = (tid >> 4) * 272 + (tid & 15) * 16;
        const bf16_t* vg0 = VT + (size_t)(h * 256 + (tid >> 2)) * MTOK + tok0 + 8 * (tid & 3);
        const bf16_t* vg1 = vg0 + (size_t)128 * MTOK;
        const int vl0 = KSL + (tid >> 2) * 80 + (tid & 3) * 16, vl1 = vl0 + 128 * 80;
        const int krow = 8 * (fr >> 2) + (fr & 3);
        u32x4 rk = *(const u32x4*)kg, rv0 = *(const u32x4*)vg0, rv1 = *(const u32x4*)vg1;
        __syncthreads();
        *(LAS u32x4*)(ldsb + SOFF + kl) = rk; *(LAS u32x4*)(ldsb + SOFF + vl0) = rv0; *(LAS u32x4*)(ldsb + SOFF + vl1) = rv1;
        __syncthreads();
#pragma unroll 1
        for (int s = 0; s < 8; ++s) {
            LAS unsigned char* cur = ldsb + SOFF + (s & 1) * SBUF; LAS unsigned char* nxt = ldsb + SOFF + ((s + 1) & 1) * SBUF;
            if (s < 7) { rk = *(const u32x4*)(kg + (size_t)(32 * (s + 1)) * 512); rv0 = *(const u32x4*)(vg0 + 32 * (s + 1)); rv1 = *(const u32x4*)(vg1 + 32 * (s + 1)); }
            f32x4 st[2][2];
#pragma unroll
            for (int a01 = 0; a01 < 2; ++a01) { st[a01][0] = (f32x4){0.f, 0.f, 0.f, 0.f}; st[a01][1] = (f32x4){0.f, 0.f, 0.f, 0.f};
                const LAS unsigned char* kp = cur + (krow + 4 * a01) * 272 + 16 * fq;
#pragma unroll
                for (int ks = 0; ks < 4; ++ks) { const bf16x8 kf = *(const LAS bf16x8*)(kp + 64 * ks);
                    st[a01][0] = MFMA16(kf, QF(0, ks), st[a01][0]); st[a01][1] = MFMA16(kf, QF(1, ks), st[a01][1]); }
#pragma unroll
                for (int mi = 0; mi < 2; ++mi)
#pragma unroll
                    for (int v = 0; v < 4; ++v) { const int d = (32 * wave + 16 * mi + fr) - (32 * s + 8 * fq + 4 * a01 + v);
                        st[a01][mi][v] *= exp2f(d >= 0 ? lgf * (float)d : lgb * (float)(-d)); } }
            const bf16x8 pf0 = mk8(cvt_pk_bf16(st[0][0][0], st[0][0][1]), cvt_pk_bf16(st[0][0][2], st[0][0][3]), cvt_pk_bf16(st[1][0][0], st[1][0][1]), cvt_pk_bf16(st[1][0][2], st[1][0][3]));
            const bf16x8 pf1 = mk8(cvt_pk_bf16(st[0][1][0], st[0][1][1]), cvt_pk_bf16(st[0][1][2], st[0][1][3]), cvt_pk_bf16(st[1][1][0], st[1][1][1]), cvt_pk_bf16(st[1][1][2], st[1][1][3]));
            const LAS unsigned char* vp = cur + KSL + fr * 80 + 16 * fq;
#pragma unroll
            for (int dt = 0; dt < 16; ++dt) { const bf16x8 vf = *(const LAS bf16x8*)(vp + dt * 1280);
                acc[dt][0] = MFMA16(vf, pf0, acc[dt][0]); acc[dt][1] = MFMA16(vf, pf1, acc[dt][1]); }
            if (s < 7) { *(LAS u32x4*)(nxt + kl) = rk; *(LAS u32x4*)(nxt + vl0) = rv0; *(LAS u32x4*)(nxt + vl1) = rv1; }
            __syncthreads();
        }
        const bf16_t* sg0 = ST + ((size_t)(bh * 32 + c) * 2) * 32768 + (size_t)(tid >> 2) * 128 + 8 * (tid & 3);
        const bf16_t* sg1 = sg0 + (size_t)128 * 128;
        rv0 = *(const u32x4*)sg0; rv1 = *(const u32x4*)sg1;
        *(LAS u32x4*)(ldsb + SOFF + vl0) = rv0; *(LAS u32x4*)(ldsb + SOFF + vl1) = rv1;
        __syncthreads();
        const int i0 = 32 * wave + fr;
#pragma unroll 1
        for (int z = 0; z < 8; ++z) {
            LAS unsigned char* cur = ldsb + SOFF + (z & 1) * SBUF; LAS unsigned char* nxt = ldsb + SOFF + ((z + 1) & 1) * SBUF;
            const int dir = z >> 2, ks = z & 3;
            if (z < 7) { const int z1 = z + 1; const size_t o = (size_t)(z1 >> 2) * 32768 + 32 * (z1 & 3); rv0 = *(const u32x4*)(sg0 + o); rv1 = *(const u32x4*)(sg1 + o); }
            const float sc0 = dir ? exp2f(lgb * (float)(256 - i0)) : exp2f(lgf * (float)(i0 + 1));
            const float sc1 = dir ? exp2f(lgb * (float)(256 - i0 - 16)) : exp2f(lgf * (float)(i0 + 17));
            const bf16x8 qs0 = scale8(qL[ks * 64], sc0), qs1 = scale8(qL[(4 + ks) * 64], sc1);
            const LAS unsigned char* sp = cur + KSL + fr * 80 + 16 * fq;
#pragma unroll
            for (int dt = 0; dt < 16; ++dt) { const bf16x8 sf = *(const LAS bf16x8*)(sp + dt * 1280);
                acc[dt][0] = MFMA16(sf, qs0, acc[dt][0]); acc[dt][1] = MFMA16(sf, qs1, acc[dt][1]); }
            if (z < 7) { *(LAS u32x4*)(nxt + vl0) = rv0; *(LAS u32x4*)(nxt + vl1) = rv1; }
            __syncthreads();
        }
#pragma unroll
        for (int mi = 0; mi < 2; ++mi) {
            float sm = 0.f;
#pragma unroll
            for (int dt = 0; dt < 16; ++dt) sm += (acc[dt][mi][0] + acc[dt][mi][1]) + (acc[dt][mi][2] + acc[dt][mi][3]);
            sm += __shfl_xor(sm, 16); sm += __shfl_xor(sm, 32);
            const float mu = sm * (1.f / 256.f); float sq = 0.f;
#pragma unroll
            for (int dt = 0; dt < 16; ++dt) { const f32x4 d = acc[dt][mi] - mu; sq += (d[0] * d[0] + d[1] * d[1]) + (d[2] * d[2] + d[3] * d[3]); }
            sq += __shfl_xor(sq, 16); sq += __shfl_xor(sq, 32);
            const float rstd = 1.f / sqrtf(sq * (1.f / 256.f) + GN_EPS);
            bf16_t* gp = GR + (tok0 + 32 * wave + 16 * mi + fr) * 1024 + h * 256 + 4 * fq;
#pragma unroll
            for (int dt = 0; dt < 16; ++dt) { const u32x2 gw = *(const u32x2*)(gp + 16 * dt);
                const float g0 = bflo(gw.x), g1 = bfhi(gw.x), g2 = bflo(gw.y), g3 = bfhi(gw.y); const f32x4 o = (acc[dt][mi] - mu) * rstd;
                u32x2 w; w.x = cvt_pk_bf16(g0 * sigm(g0) * o[0], g1 * sigm(g1) * o[1]); w.y = cvt_pk_bf16(g2 * sigm(g2) * o[2], g3 * sigm(g3) * o[3]);
                *(u32x2*)(gp + 16 * dt) = w; }
        }
    }
    __syncthreads();
}
#undef QF
template <int RS> __device__ __forceinline__ void conv_glu_phase(const bf16_t* H, bf16_t* U, int NP, int aoff, const float* cw, const float* cb, int tid, int bid) {
    const int ncg = NP / 8, nitems = (MTOK / RS) * ncg;
    for (int item = bid * 512 + tid; item < nitems; item += gridDim.x * 512) {
        const int cgp = item % ncg, strip = item / ncg, j0 = cgp * 8, t0 = strip * RS;
        float wa[3][8], wb[3][8], ba[8], bb[8];
#pragma unroll
        for (int e = 0; e < 8; ++e) {
#pragma unroll
            for (int k = 0; k < 3; ++k) { wa[k][e] = cw[k * 5632 + aoff + j0 + e]; wb[k][e] = cw[k * 5632 + 2816 + aoff + j0 + e]; }
            ba[e] = cb[aoff + j0 + e]; bb[e] = cb[2816 + aoff + j0 + e]; }
        const bf16_t* hp = H + (size_t)t0 * (2 * NP) + j0;
        u32x4 pa, pb, ca, cb_, na, nb;
        const u32x4 z4 = {0u, 0u, 0u, 0u};
        if ((t0 & (SEQ - 1)) != 0) { pa = *(const u32x4*)(hp - (size_t)(2 * NP)); pb = *(const u32x4*)(hp - (size_t)(2 * NP) + NP); } else { pa = z4; pb = z4; }
        ca = *(const u32x4*)hp; cb_ = *(const u32x4*)(hp + NP);
#pragma unroll 1
        for (int r = 0; r < RS; ++r) {
            const int t = t0 + r;
            if ((t & (SEQ - 1)) != SEQ - 1) { na = *(const u32x4*)(hp + (size_t)(r + 1) * (2 * NP)); nb = *(const u32x4*)(hp + (size_t)(r + 1) * (2 * NP) + NP); } else { na = z4; nb = z4; }
            float o[8];
#define CG_ONE(e, PW, CW, NW, PWB, CWB, NWB, LOHI) { const float a = wa[0][e] * LOHI(PW) + wa[1][e] * LOHI(CW) + wa[2][e] * LOHI(NW) + ba[e]; \
                const float bq = wb[0][e] * LOHI(PWB) + wb[1][e] * LOHI(CWB) + wb[2][e] * LOHI(NWB) + bb[e]; o[e] = gelu_tanh(a) * bq; }
            CG_ONE(0, pa.x, ca.x, na.x, pb.x, cb_.x, nb.x, bflo) CG_ONE(1, pa.x, ca.x, na.x, pb.x, cb_.x, nb.x, bfhi)
            CG_ONE(2, pa.y, ca.y, na.y, pb.y, cb_.y, nb.y, bflo) CG_ONE(3, pa.y, ca.y, na.y, pb.y, cb_.y, nb.y, bfhi)
            CG_ONE(4, pa.z, ca.z, na.z, pb.z, cb_.z, nb.z, bflo) CG_ONE(5, pa.z, ca.z, na.z, pb.z, cb_.z, nb.z, bfhi)
            CG_ONE(6, pa.w, ca.w, na.w, pb.w, cb_.w, nb.w, bflo) CG_ONE(7, pa.w, ca.w, na.w, pb.w, cb_.w, nb.w, bfhi)
#undef CG_ONE
            u32x4 w; w.x = cvt_pk_bf16(o[0], o[1]); w.y = cvt_pk_bf16(o[2], o[3]); w.z = cvt_pk_bf16(o[4], o[5]); w.w = cvt_pk_bf16(o[6], o[7]);
            *(u32x4*)(U + (size_t)t * NP + j0) = w;
            pa = ca; pb = cb_; ca = na; cb_ = nb;
        }
    }
}

#ifndef PH_MASK
#define PH_MASK 0xFFFFFFFFu
#endif
#define PH(n) ((PH_MASK >> (n)) & 1u)
struct Args { const float* in[19]; float* out; unsigned char* ws; };
constexpr int LDS_BYTES = 147456;
__device__ __forceinline__ int otid() { int t = threadIdx.x; asm volatile("" : "+v"(t)); return t; }
__device__ __forceinline__ int obid() { int b = blockIdx.x; asm volatile("" : "+s"(b)); return b; }
typedef const unsigned long long __attribute__((address_space(4)))* kptr_t;
__device__ __forceinline__ kptr_t kargs_() { kptr_t p = (kptr_t)__builtin_amdgcn_kernarg_segment_ptr(); asm volatile("" : "+s"(p)); return p; }
#define KIN(k) ((const float*)kargs_()[k])
#define KOUT ((float*)kargs_()[19])
#define KWS ((unsigned char*)kargs_()[20])
#define LOADIN(in) In in; { kptr_t kp_ = kargs_(); _Pragma("unroll") for (int i_ = 0; i_ < 19; ++i_) in.p[i_] = (const float*)kp_[i_]; }
#define TSET const int tid = otid(), lane = tid & 63, wave = __builtin_amdgcn_readfirstlane(tid >> 6), bid = obid(), gw = bid * 8 + wave, NGW = (int)gridDim.x * 8; (void)lane; (void)gw; (void)NGW; (void)tid;
#define GEMM(EpiT, Aptr, Bptr, Mv, Nv, Kv, Eobj) do { Gemm g_{(const bf16_t*)(Aptr), (const bf16_t*)(Bptr), (Mv), (Nv), (Kv)}; StaticOrder S_; S_.init((Mv), (Nv), (int)gridDim.x, obid()); \
        gemm_phase<EpiT, StaticOrder, true, true>(ldsp, g_, S_, (Eobj)); } while (0)
#define GEMM_CONV(EpiT, Aptr, Bptr, Nv, Kv, Eobj) do { Gemm g_{(const bf16_t*)(Aptr), (const bf16_t*)(Bptr), 132 * 256, (Nv), (Kv)}; StaticOrder S_; S_.init(132 * 256, (Nv), (int)gridDim.x, obid()); \
        gemm_phase<EpiT, StaticOrder, true, true, true>(ldsp, g_, S_, (Eobj)); } while (0)
#define PHASE_FENCE() do { __builtin_amdgcn_fence(__ATOMIC_RELEASE, "agent"); __builtin_amdgcn_fence(__ATOMIC_ACQUIRE, "agent"); __syncthreads(); } while (0)


#define RLX_AGENT __ATOMIC_RELAXED, __HIP_MEMORY_SCOPE_AGENT
#define XB_TMO      128
#define XB_XCNT(j)  (256  + 64 * (j))
#define XB_XSUB(j)  (1280 + 64 * (j))
#define XB_XGEN(j)  (2304 + 64 * (j))
#define XB_TOP      3328
#define XB_TOPGEN   3392
#define XCD_BAR_WORDS 3456
#define XB_SPIN_CAP (1u << 18)

__device__ __forceinline__ unsigned xb_ld(unsigned* p)              { return __hip_atomic_load(p, __ATOMIC_RELAXED, __HIP_MEMORY_SCOPE_AGENT); }
__device__ __forceinline__ unsigned xb_add(unsigned* p, unsigned v) { return __hip_atomic_fetch_add(p, v, __ATOMIC_RELAXED, __HIP_MEMORY_SCOPE_AGENT); }
__device__ __forceinline__ unsigned xb_xcc_id() { return (unsigned)__builtin_amdgcn_s_getreg((3 << 11) | 20) & 0xFu; }
#define XB_SPIN(cond, bar) do { unsigned _sp = 0; while (cond) { __builtin_amdgcn_s_sleep(1); \
    if ((++_sp & 255u) == 0u) { if (xb_ld(&(bar)[XB_TMO])) break; if (_sp > XB_SPIN_CAP) { atomicAdd(&(bar)[XB_TMO], 1u); break; } } } } while (0)

struct XcdBarrier {
    unsigned* bar; unsigned x;
    volatile LAS unsigned* st;
};

__device__ __forceinline__ XcdBarrier xcd_barrier_post(unsigned* bar, volatile LAS unsigned* st) {
    XcdBarrier b; b.bar = bar; b.x = xb_xcc_id(); b.st = st;
    if (threadIdx.x == 0) (void)xb_add(&bar[XB_XCNT(b.x)], 1u);
    return b;
}
__device__ __forceinline__ void xcd_barrier_complete(unsigned* bar, unsigned x, unsigned& nloc, unsigned& nx) {
    const unsigned G = gridDim.x * gridDim.y * gridDim.z;
    unsigned sum, cnt, mine, sp = 0u;
    for (;;) {
        sum = 0u; cnt = 0u; mine = 0u;
#pragma unroll
        for (unsigned j = 0; j < 16; ++j) { const unsigned c = xb_ld(&bar[XB_XCNT(j)]); sum += c; cnt += (c > 0u) ? 1u : 0u; mine = (j == x) ? c : mine; }
        if (sum == G) break;
        __builtin_amdgcn_s_sleep(1);
        if ((++sp & 255u) == 0u) { if (xb_ld(&bar[XB_TMO])) break; if (sp > XB_SPIN_CAP) { atomicAdd(&bar[XB_TMO], 1u); break; } }
    }
    nloc = mine > 0u ? mine : 1u; nx = cnt > 0u ? cnt : 1u;
}

__device__ __forceinline__ void xcd_barrier(const XcdBarrier& b) {
    asm volatile("s_waitcnt vmcnt(0)" ::: "memory");
    __syncthreads();
    if (threadIdx.x == 0) {
        unsigned* bar = b.bar;
        __builtin_amdgcn_s_waitcnt(0);
        unsigned nloc = b.st[0], nx = b.st[1];
        if (nloc == 0u) { xcd_barrier_complete(bar, b.x, nloc, nx); b.st[0] = nloc; b.st[1] = nx; }
        const unsigned old = xb_add(&bar[XB_XSUB(b.x)], 1u);
        const unsigned gen = old / nloc;
        if (old + 1u == (gen + 1u) * nloc) {
            __builtin_amdgcn_fence(__ATOMIC_RELEASE, "agent");
            asm volatile("s_waitcnt vmcnt(0)" ::: "memory");
            const unsigned og = xb_add(&bar[XB_TOP], 1u);
            const unsigned tg = og / nx;
            if (og + 1u == (tg + 1u) * nx) xb_add(&bar[XB_TOPGEN], 1u);
            else XB_SPIN(xb_ld(&bar[XB_TOPGEN]) == tg, bar);
            __builtin_amdgcn_fence(__ATOMIC_ACQUIRE, "agent");
            xb_add(&bar[XB_XGEN(b.x)], 1u);
            asm volatile("s_waitcnt vmcnt(0)" ::: "memory");
        } else {
            XB_SPIN(xb_ld(&bar[XB_XGEN(b.x)]) == gen, bar);
            __builtin_amdgcn_fence(__ATOMIC_ACQUIRE, "agent");
            asm volatile("s_waitcnt vmcnt(0)" ::: "memory");
        }
    }
    __syncthreads();
}

#define XBAR() do { XcdBarrier b_; b_.bar = (unsigned*)KWS; b_.x = xb_xcc_id(); b_.st = (volatile LAS unsigned*)(lds + 131072 + 2048); xcd_barrier(b_); } while (0)

#ifndef PROBE_SEL
#define PROBE_SEL 0u
#endif
#ifndef PROBE_K
#define PROBE_K 8
#endif
#define STAMP(cat) do { if (PROBE_SEL != 0u) { if (blockIdx.x == 0 && threadIdx.x == 0) { volatile LAS unsigned long long* tw_ = (volatile LAS unsigned long long*)(lds + 131072 + 1024); \
        const unsigned long long t_ = __builtin_amdgcn_s_memrealtime(); if ((PROBE_SEL >> (cat)) & 1u) tw_[1] += t_ - tw_[0]; tw_[0] = t_; } } } while (0)
#define SYNC() do { XBAR(); STAMP(15); } while (0)
#define P_(off) ((bf16_t*)(KWS + (off)))
#define cosT ((float*)(KWS + WS_COS))
#define sinT ((float*)(KWS + WS_SIN))
#define Wb P_(WS_W)
#define xout KOUT
template <int layer> __device__ __forceinline__ void layer_body(unsigned char* lds, PG8_LAS unsigned char* ldsp, cg::grid_group& grid) {
        if (PH(1)) { EpiProj E{P_(WS_QNA), P_(WS_KNA), P_(WS_QR), P_(WS_KR), P_(WS_KT), P_(WS_GR), cosT, sinT}; GEMM(EpiProj, P_(WS_XB), Wb + W_IN, MTOK, 3072, 1024, E); }
        STAMP(1);
        __syncthreads();
        if (PH(2)) { EpiVT E{P_(WS_VTNA), P_(WS_VTR)}; GEMM(EpiVT, Wb + W_IN + (size_t)3072 * 1024, P_(WS_XB), 1536, MTOK, 1024, E); }
        STAMP(1);
        SYNC();
        if (PH(3)) { TSET ret_kv_phase(P_(WS_KT), P_(WS_VTR), P_(WS_ST), KIN(4) + layer * 4, KIN(5) + layer * 4, (LAS unsigned char*)lds, tid, wave, lane, bid); }
        STAMP(2);
        __syncthreads();
        if (PH(4)) { TSET na_phase(P_(WS_QNA), P_(WS_KNA), P_(WS_VTNA), KIN(3) + layer * 3720, (LAS unsigned char*)lds, tid, wave, lane, bid); }
        STAMP(3);
        SYNC();
        if (PH(5)) { TSET ret_scan_phase(P_(WS_ST), KIN(4) + layer * 4, KIN(5) + layer * 4, tid, bid); }
        STAMP(4);
        SYNC();
        if (PH(6)) { TSET ret_out_phase(P_(WS_QR), P_(WS_KR), P_(WS_VTR), P_(WS_ST), P_(WS_GR), KIN(4) + layer * 4, KIN(5) + layer * 4, (LAS unsigned char*)lds, tid, wave, lane, bid); }
        STAMP(5);
        __syncthreads();
        if (PH(7)) { EpiBf<2> E{P_(WS_GA), P_(WS_GB), 4, 1024}; GEMM(EpiBf<2>, P_(WS_XB), Wb + W_IN + (size_t)4608 * 1024, MTOK, 2048, 1024, E); }
        STAMP(6);
        SYNC();
        if (PH(8)) { EpiMerge<0> E{P_(WS_MRG), P_(WS_GA)}; GEMM(EpiMerge<0>, P_(WS_QNA), Wb + W_A, MTOK, 1024, 512, E); }
        STAMP(7);
        PHASE_FENCE();
        if (PH(9)) { EpiMerge<1> E{P_(WS_MRG), P_(WS_GB)}; GEMM(EpiMerge<1>, P_(WS_GR), Wb + W_B, MTOK, 1024, 1024, E); }
        STAMP(7);
        SYNC();
        if (PH(10)) { EpiF32<0> E{xout, layer == 0 ? KIN(0) : xout, nullptr, nullptr}; GEMM(EpiF32<0>, P_(WS_MRG), Wb + W_O, MTOK, 1024, 1024, E); }
        STAMP(7);
        SYNC();
        if (PH(11)) { TSET for (int m = gw; m < MTOK; m += NGW) ln_row(xout + (size_t)m * DM, xout + (size_t)m * DM, P_(WS_XB) + (size_t)m * DM, KIN(9) + layer * DM, KIN(10) + layer * DM, lane); }
        STAMP(8);
        SYNC();
        if (PH(12)) { EpiConv E{P_(WS_H), KIN(12) + (size_t)layer * 3 * 5632, KIN(13) + (size_t)layer * 5632}; GEMM_CONV(EpiConv, P_(WS_XB), Wb + W_UP, 5632, 1024, E); }
        STAMP(9);
        __syncthreads();
        if (PH(13)) { EpiBf<2> E{P_(WS_SG), P_(WS_SG), 1 << 20, 1024}; GEMM(EpiBf<2>, P_(WS_XB), Wb + W_PG, MTOK, 1024, 1024, E); }
        STAMP(9);
        __syncthreads();
        if (PH(14)) { EpiBf<0> E{P_(WS_ST), P_(WS_ST), 1 << 20, 1024}; GEMM(EpiBf<0>, P_(WS_PB), Wb + W_PP, MTOK, 1024, 256, E); }
        STAMP(9);
        SYNC();
        if (PH(16)) { EpiF32<3> E{xout, nullptr, P_(WS_SG), P_(WS_ST)}; GEMM(EpiF32<3>, P_(WS_H), Wb + W_D1, MTOK, 1024, 2816, E); }
        STAMP(11);
        SYNC();
        if (PH(11)) { TSET for (int m = gw; m < MTOK; m += NGW) ln_row(xout + (size_t)m * DM, xout + (size_t)m * DM, P_(WS_XB) + (size_t)m * DM, KIN(17) + layer * DM, KIN(18) + layer * DM, lane); }
        STAMP(8);
        if (layer + 1 < NLAYER) { TSET if (PH(0)) { LOADIN(in) convert_layer(in, layer + 1, Wb, P_(WS_PB), (LAS float*)(lds + wave * 16384), gw, NGW, lane); } SYNC(); }
}

__global__ void __launch_bounds__(512, 2) mk_fwd(Args args) {
    extern __shared__ __attribute__((aligned(16))) unsigned char lds[];
    cg::grid_group grid = cg::this_grid();
    PG8_LAS unsigned char* ldsp = (PG8_LAS unsigned char*)lds;
    if (PROBE_SEL != 0u) { if (blockIdx.x == 0 && threadIdx.x == 0) { volatile LAS unsigned long long* tw_ = (volatile LAS unsigned long long*)(lds + 131072 + 1024); tw_[0] = __builtin_amdgcn_s_memrealtime(); tw_[1] = 0ull; } }
    if (threadIdx.x < 2) ((volatile LAS unsigned*)(lds + 131072 + 2048))[threadIdx.x] = 0u;
    __syncthreads();
    (void)xcd_barrier_post((unsigned*)KWS, (volatile LAS unsigned*)(lds + 131072 + 2048));
    { TSET
      if (PH(0)) { LOADIN(in) convert_layer(in, 0, Wb, P_(WS_PB), (LAS float*)(lds + wave * 16384), gw, NGW, lane); }
      float* cT = cosT; float* sT = sinT;
      for (int i = bid * 512 + tid; i < SEQ * 64; i += (int)gridDim.x * 512) { const int t = i >> 6, j = i & 63;
          const float inv = powf(10000.f, -(float)j * (1.f / 64.f)); const float ang = (float)t * inv; cT[i] = cosf(ang); sT[i] = sinf(ang); }
      const float* x = KIN(0); bf16_t* XB = P_(WS_XB);
      for (size_t i = (size_t)(bid * 512 + tid) * 8; i < (size_t)MTOK * DM; i += (size_t)gridDim.x * 512 * 8) { const f32x4 a = *(const f32x4*)(x + i), b = *(const f32x4*)(x + i + 4);
          u32x4 w; w.x = cvt_pk_bf16(a[0], a[1]); w.y = cvt_pk_bf16(a[2], a[3]); w.z = cvt_pk_bf16(b[0], b[1]); w.w = cvt_pk_bf16(b[2], b[3]); *(u32x4*)(XB + i) = w; } }
    grid.sync(); STAMP(15);

    layer_body<0>(lds, ldsp, grid);
    layer_body<1>(lds, ldsp, grid);
    layer_body<2>(lds, ldsp, grid);
    layer_body<3>(lds, ldsp, grid);
    if (PROBE_SEL != 0u) { if (blockIdx.x == 0 && threadIdx.x == 0) { volatile LAS unsigned long long* tw_ = (volatile LAS unsigned long long*)(lds + 131072 + 1024);
        const unsigned long long t0_ = __builtin_amdgcn_s_memrealtime(), want_ = (unsigned long long)PROBE_K * tw_[1]; while (__builtin_amdgcn_s_memrealtime() - t0_ < want_) __builtin_amdgcn_s_sleep(8); } }
}

extern "C" void kernel_launch(void* const* d_in, const int* in_sizes, int n_in, void* d_out, int out_size, void* d_ws, size_t ws_size, hipStream_t stream) {
    static int grid = 0;
    if (grid == 0) {
        if (n_in != 19 || out_size != MTOK * DM || ws_size < WS_END) { fprintf(stderr, "kernel_launch: unexpected shapes (n_in %d out %d ws %zu)\n", n_in, out_size, ws_size); grid = -1; return; }
        int dev = 0, cus = 0;
        if (hipGetDevice(&dev) != hipSuccess || hipDeviceGetAttribute(&cus, hipDeviceAttributeMultiprocessorCount, dev) != hipSuccess) { grid = -1; return; }
        if (hipFuncSetAttribute((const void*)mk_fwd, hipFuncAttributeMaxDynamicSharedMemorySize, LDS_BYTES) != hipSuccess) { fprintf(stderr, "kernel_launch: hipFuncSetAttribute failed\n"); grid = -1; return; }
        int per_cu = 0;
        if (hipOccupancyMaxActiveBlocksPerMultiprocessor(&per_cu, (const void*)mk_fwd, 512, LDS_BYTES) != hipSuccess || per_cu < 1) fprintf(stderr, "kernel_launch: occupancy query says %d\n", per_cu);
        (void)hipGetLastError();
        grid = cus;
    }
    if (grid < 0) return;
    if (hipMemsetAsync(d_ws, 0, 16384, stream) != hipSuccess) { fprintf(stderr, "kernel_launch: hipMemsetAsync failed\n"); return; }
    Args a{};
    for (int i = 0; i < 19; ++i) a.in[i] = (const float*)d_in[i];
    a.out = (float*)d_out; a.ws = (unsigned char*)d_ws;
    void* kargs[] = {&a};
    hipError_t e = hipLaunchCooperativeKernel((const void*)mk_fwd, dim3(grid), dim3(512), kargs, LDS_BYTES, stream);
    if (e != hipSuccess) fprintf(stderr, "kernel_launch: cooperative launch failed: %s (grid %d)\n", hipGetErrorString(e), grid);
}
```
